# Optimizing an MI355X kernel written in HIP

```python
import math
import jax, jax.numpy as jnp
from jax import lax
import numpy as np

D_MODEL = 2048
BATCH = 1
SEQ = 16384
DEPTH = 2

N_META = 16
M_HEADS = 4
M_QK = 128
M_V = 256
M_CHUNK = 64
CONV_W = 4
F_HEADS = 8
F_HD = 128
Q_BLOCK = 128
D_FF = 4 * D_MODEL
M_QK_W = M_HEADS * M_QK
M_V_W = M_HEADS * M_V
F_W = F_HEADS * F_HD
MIX_WIDTH = M_V_W + F_W
SPLIT_SIZES = (M_QK_W, M_QK_W, M_V_W, M_HEADS, M_HEADS, M_V_W, F_W, F_W, F_W, F_HEADS)
IN_WIDTH = 2 * M_QK_W + 2 * M_V_W + 2 * M_HEADS + 3 * F_W + F_HEADS
DN_ALPHA = (2 * DEPTH) ** 0.25
DN_BETA = (8 * DEPTH) ** -0.25
LN_EPS = 1e-5
RMS_EPS = 1e-6
NEG = -1e30

kernel_name = "hymba_mlstm_fox_deepnorm"


def layer_norm(x, g, b):
    xf = x.astype(jnp.float32)
    mu = jnp.mean(xf, axis=-1, keepdims=True)
    var = jnp.mean(jnp.square(xf - mu), axis=-1, keepdims=True)
    return ((xf - mu) * lax.rsqrt(var + LN_EPS) * g + b).astype(x.dtype)


def head_rmsnorm(h, g):
    H, d = h.shape[-2], h.shape[-1]
    hf = h.astype(jnp.float32)
    hf = hf * lax.rsqrt(jnp.mean(jnp.square(hf), axis=-1, keepdims=True) + RMS_EPS)
    return (hf * g.reshape(H, d)).astype(h.dtype)


def causal_conv(x, w, b):
    L = x.shape[1]
    xp = jnp.pad(x, ((0, 0), (CONV_W - 1, 0), (0, 0)))
    out = b
    for k in range(CONV_W):
        out = out + xp[:, k:k + L, :] * w[k]
    return out


def pad_front(x, p, value=0.0):
    pads = [(0, 0)] * x.ndim
    pads[1] = (p, 0)
    return jnp.pad(x, pads, constant_values=value)


def mlstm(q, k, v, i_pre, f_pre):
    B, L, H, dqk = q.shape
    dv = v.shape[-1]
    dtype = v.dtype
    P = M_CHUNK - N_META
    Lp = P + L
    NC = Lp // M_CHUNK
    f32 = jnp.float32
    qp = pad_front(q.astype(f32) * (dqk ** -0.5), P)
    kp = pad_front(k.astype(f32), P)
    vp = pad_front(v.astype(f32), P)
    log_i = pad_front(i_pre.astype(f32), P, NEG)
    log_f = pad_front(jax.nn.log_sigmoid(f_pre.astype(f32)), P, 0.0)

    def chunks(a):
        return a.reshape(B, NC, M_CHUNK, H, a.shape[-1]).transpose(0, 3, 1, 2, 4)

    def gchunks(a):
        return a.reshape(B, NC, M_CHUNK, H).transpose(0, 3, 1, 2)

    qc, kc, vc = chunks(qp), chunks(kp), chunks(vp)
    li, lf = gchunks(log_i), gchunks(log_f)

    b = jnp.cumsum(lf, axis=-1)
    g = b[..., -1]
    a = g[..., None] - b + li
    m_loc = jnp.max(a, axis=-1)
    w_loc = jnp.exp(a - m_loc[..., None])
    C_loc = jnp.einsum('bhncd,bhnce,bhnc->bhnde', kc, vc, w_loc)
    n_loc = jnp.einsum('bhncd,bhnc->bhnd', kc, w_loc)

    def step(carry, inp):
        C, n, m = carry
        Cl, nl, ml, gl = inp
        m_new = jnp.maximum(gl + m, ml)
        s_prev = jnp.exp(gl + m - m_new)
        s_loc = jnp.exp(ml - m_new)
        C_new = s_prev[..., None, None] * C + s_loc[..., None, None] * Cl
        n_new = s_prev[..., None] * n + s_loc[..., None] * nl
        return (C_new, n_new, m_new), (C, n, m)

    init = (jnp.zeros((B, H, dqk, dv), f32), jnp.zeros((B, H, dqk), f32), jnp.zeros((B, H), f32))
    xs = (jnp.moveaxis(C_loc, 2, 0), jnp.moveaxis(n_loc, 2, 0),
          jnp.moveaxis(m_loc, 2, 0), jnp.moveaxis(g, 2, 0))
    _, (C_prev, n_prev, m_prev) = lax.scan(step, init, xs)
    C_prev = jnp.moveaxis(C_prev, 0, 2)
    n_prev = jnp.moveaxis(n_prev, 0, 2)
    m_prev = jnp.moveaxis(m_prev, 0, 2)

    causal = jnp.tril(jnp.ones((M_CHUNK, M_CHUNK), dtype=bool))
    D = b[..., :, None] - b[..., None, :] + li[..., None, :]
    D = jnp.where(causal, D, NEG)
    inter_log = b + m_prev[..., None]
    m_t = jnp.maximum(inter_log, jnp.max(D, axis=-1))
    W = jnp.exp(D - m_t[..., None]) * jnp.einsum('bhntd,bhnsd->bhnts', qc, kc)
    s_inter = jnp.exp(inter_log - m_t)
    num = jnp.einsum('bhnts,bhnse->bhnte', W, vc) + \
        s_inter[..., None] * jnp.einsum('bhntd,bhnde->bhnte', qc, C_prev)
    nq = jnp.sum(W, axis=-1) + s_inter * jnp.einsum('bhntd,bhnd->bhnt', qc, n_prev)
    h = num / jnp.maximum(jnp.abs(nq), jnp.exp(-m_t))[..., None]
    h = h.transpose(0, 2, 3, 1, 4).reshape(B, Lp, H, dv)[:, P:]
    return h.astype(dtype)


def forgetting_attention(q, k, v, f_pre):
    B, L, H, d = q.shape
    dtype = v.dtype
    P = Q_BLOCK - N_META
    Lp = P + L
    NB = Lp // Q_BLOCK
    f32 = jnp.float32
    qp = pad_front(q.astype(f32) * (d ** -0.5), P).transpose(0, 2, 1, 3)
    kp = pad_front(k.astype(f32), P).transpose(0, 2, 1, 3)
    vp = pad_front(v.astype(f32), P).transpose(0, 2, 1, 3)
    log_f = pad_front(jax.nn.log_sigmoid(f_pre.astype(f32)), P, 0.0)
    c = jnp.cumsum(log_f, axis=1).transpose(0, 2, 1)
    key_pos = jnp.arange(Lp)
    qb = qp.reshape(B, H, NB, Q_BLOCK, d).transpose(2, 0, 1, 3, 4)
    cb = c.reshape(B, H, NB, Q_BLOCK).transpose(2, 0, 1, 3)

    def block(args):
        idx, q_blk, c_blk = args
        q_pos = idx * Q_BLOCK + jnp.arange(Q_BLOCK)
        s = jnp.einsum('bhtd,bhsd->bhts', q_blk, kp) + c_blk[..., :, None] - c[..., None, :]
        mask = (key_pos[None, :] <= q_pos[:, None]) & (key_pos[None, :] >= P)
        p = jax.nn.softmax(jnp.where(mask, s, NEG), axis=-1)
        return jnp.einsum('bhts,bhsd->bhtd', p, vp)

    o = lax.map(block, (jnp.arange(NB, dtype=jnp.int32), qb, cb))
    o = o.transpose(1, 0, 3, 2, 4).reshape(B, Lp, H, d)[:, P:]
    return o.astype(dtype)


def hybrid_mixer(x, w_in, conv_w, conv_b, m_i_bias, m_f_bias, m_norm, f_f_bias, f_norm, w_out):
    B, L, _ = x.shape
    proj = x @ w_in
    offsets = [int(o) for o in np.cumsum(SPLIT_SIZES)[:-1]]
    mq, mk, mv, mi, mf, mo, fq, fk, fv, ff = jnp.split(proj, offsets, axis=-1)
    qk = jax.nn.silu(causal_conv(jnp.concatenate([mq, mk], axis=-1), conv_w, conv_b))
    mq, mk = jnp.split(qk, 2, axis=-1)
    h_m = mlstm(mq.reshape(B, L, M_HEADS, M_QK), mk.reshape(B, L, M_HEADS, M_QK),
                mv.reshape(B, L, M_HEADS, M_V), mi + m_i_bias, mf + m_f_bias)
    h_m = head_rmsnorm(h_m, m_norm).reshape(B, L, M_V_W) * jax.nn.sigmoid(mo)
    h_f = forgetting_attention(fq.reshape(B, L, F_HEADS, F_HD), fk.reshape(B, L, F_HEADS, F_HD),
                               fv.reshape(B, L, F_HEADS, F_HD), ff + f_f_bias)
    h_f = head_rmsnorm(h_f, f_norm).reshape(B, L, F_W)
    return jnp.concatenate([h_m, h_f], axis=-1) @ w_out


def sq_relu_mlp(x, w_up, w_down):
    return jnp.square(jax.nn.relu(x @ w_up)) @ w_down


def setup_inputs(seed: int = 0) -> dict:
    key = jax.random.key(seed)
    ks = jax.random.split(key, 17)
    f32 = jnp.float32
    nrm = lambda k, shape, s: jax.random.normal(k, shape, f32) * s
    m_f_base = jnp.linspace(3.0, 6.0, M_HEADS, dtype=f32)
    f_f_base = jnp.linspace(1.0, 5.0, F_HEADS, dtype=f32)
    return {
        "x": nrm(ks[0], (BATCH, SEQ, D_MODEL), 1.0),
        "meta": nrm(ks[1], (N_META, D_MODEL), 1.0),
        "w_in": nrm(ks[2], (DEPTH, D_MODEL, IN_WIDTH), D_MODEL ** -0.5),
        "conv_w": nrm(ks[3], (DEPTH, CONV_W, 2 * M_QK_W), CONV_W ** -0.5),
        "conv_b": nrm(ks[4], (DEPTH, 2 * M_QK_W), 0.01),
        "m_i_bias": -1.0 + nrm(ks[5], (DEPTH, M_HEADS), 0.1),
        "m_f_bias": m_f_base + nrm(ks[6], (DEPTH, M_HEADS), 0.1),
        "m_norm": 1.0 + nrm(ks[7], (DEPTH, M_V_W), 0.02),
        "f_f_bias": f_f_base + nrm(ks[8], (DEPTH, F_HEADS), 0.1),
        "f_norm": 1.0 + nrm(ks[9], (DEPTH, F_W), 0.02),
        "w_out": nrm(ks[10], (DEPTH, MIX_WIDTH, D_MODEL), DN_BETA * MIX_WIDTH ** -0.5),
        "ln1_g": 1.0 + nrm(ks[11], (DEPTH, D_MODEL), 0.02),
        "ln1_b": nrm(ks[12], (DEPTH, D_MODEL), 0.02),
        "w_up": nrm(ks[13], (DEPTH, D_MODEL, D_FF), D_MODEL ** -0.5),
        "w_down": nrm(ks[14], (DEPTH, D_FF, D_MODEL), DN_BETA * D_FF ** -0.5),
        "ln2_g": 1.0 + nrm(ks[15], (DEPTH, D_MODEL), 0.02),
        "ln2_b": nrm(ks[16], (DEPTH, D_MODEL), 0.02),
    }


def reference(x, meta, w_in, conv_w, conv_b, m_i_bias, m_f_bias, m_norm, f_f_bias, f_norm,
              w_out, ln1_g, ln1_b, w_up, w_down, ln2_g, ln2_b):
    B = x.shape[0]
    meta_b = jnp.broadcast_to(meta[None].astype(x.dtype), (B, N_META, D_MODEL))
    h = jnp.concatenate([meta_b, x], axis=1)
    for l in range(DEPTH):
        y = hybrid_mixer(h, w_in[l], conv_w[l], conv_b[l], m_i_bias[l], m_f_bias[l], m_norm[l],
                         f_f_bias[l], f_norm[l], w_out[l])
        h = layer_norm(DN_ALPHA * h + y, ln1_g[l], ln1_b[l])
        h = layer_norm(DN_ALPHA * h + sq_relu_mlp(h, w_up[l], w_down[l]), ln2_g[l], ln2_b[l])
    return h[:, N_META:]
```

```cpp
#include <hip/hip_runtime.h>
#include <hip/hip_cooperative_groups.h>
#include <cstdio>
#include <cstdint>
namespace cg = cooperative_groups;

#ifndef MK_SINGLE
#define MK_SINGLE 1
#endif

namespace pg8 {
#define PG8_LAS __attribute__((address_space(3)))
typedef unsigned short bf16_t;
typedef short bf16x8 __attribute__((ext_vector_type(8)));
typedef float f32x4 __attribute__((ext_vector_type(4)));
typedef unsigned u32x4 __attribute__((ext_vector_type(4)));
constexpr int BM = 256, BK = 64, HALF = 128, HTB = HALF * BK * 2  , STAGE_BYTES = 8 * HTB, NXCD = 8, WGM = 8;

__host__ __device__ __forceinline__ int lds_byte(int r, int c) { const int st = (r >> 4) * 2 + (c >> 5), rr = r & 15, cc = c & 31, ob = rr * 64 + cc * 2; return st * 1024 + (ob ^ (((ob >> 9) & 1) << 5)); }
__host__ __device__ __forceinline__ void stage_rc(int b, int& R, int& C) { const int st = b / 1024, sb = b % 1024, swz = sb ^ (((sb >> 9) & 1) << 5); R = (st >> 1) * 16 + swz / 64; C = (st & 1) * 32 + (swz % 64) / 2; }
__host__ __device__ __forceinline__ int perm32(int rho) { const int n = rho >> 4, i = rho & 15; return 8 * (i >> 2) + 4 * n + (i & 3); }

struct Unit { int pm, pn; };
struct Gemm { const bf16_t* A; const bf16_t* Bt; int M, N, K, ldb; };

struct StaticOrder {
    int nM, nN, nwg, G, c;
    __host__ __device__ void init(int M, int N, int G_, int c_) { nM = M / BM; nN = N / BM; nwg = nM * nN; G = G_; c = c_; }
    __host__ __device__ bool next(int i, Unit& u) const {
        const long L = (long)i * G + c; if (L >= nwg) return false;
        int wgid = (int)L; { const int q = nwg / NXCD, r = nwg % NXCD, xcd = wgid % NXCD, off = wgid / NXCD; wgid = (xcd < r ? xcd * (q + 1) : r * (q + 1) + (xcd - r) * q) + off; }
        const int nig = WGM * nN, gid = wgid / nig, fm = gid * WGM, gsz = (nM - fm) < WGM ? (nM - fm) : WGM;
        u.pm = fm + ((wgid % nig) % gsz); u.pn = (wgid % nig) / gsz; return true;
    }
    __device__ __forceinline__ void a_ready(const Unit&) const {}
    __device__ __forceinline__ void done(const Unit&) const {}
};

template <class Epi, class Sched, bool ALIGN_EPI = false, bool SP2 = false>
__device__ __forceinline__ void gemm_phase(PG8_LAS unsigned char* lds, const Gemm g, const Sched& S, const Epi& E) {
    int tidl_ = threadIdx.x; asm volatile("" : "+v"(tidl_));
    const int tid = tidl_, wid = __builtin_amdgcn_readfirstlane(tid >> 6), lane = tid & 63, wr = wid >> 2, wc = wid & 3, fr = lane & 15, fq = lane >> 4;
    const int K = g.K, nt = K / BK;
    unsigned voffA[2], voffB[2];
#pragma unroll
    for (int i = 0; i < 2; ++i) { int R, C; stage_rc(tid * 16 + i * 8192, R, C); const int Rb = Epi::PERM ? ((R & ~31) + perm32(R & 31)) : R;
        voffA[i] = (unsigned)(R * K + C) * 2u; voffB[i] = (unsigned)(Rb * g.ldb + C) * 2u; }
    const size_t kstep = (size_t)(BK * 2);
    const size_t hstep = (size_t)HALF * K * 2;
    const size_t tstep = 2 * hstep;
    const size_t hstepB = (size_t)HALF * g.ldb * 2, tstepB = 2 * hstepB;
    const unsigned ldsw = (unsigned)wid * 1024u;
    const int aoff = lds_byte(wr * 64 + fr, fq * 8), boff = lds_byte(wc * 32 + fr, fq * 8);
#define PG8_SA(b, h) (((b) * 2 + (h)) * HTB)
#define PG8_SB(b, h) ((4 + (b) * 2 + (h)) * HTB)
#define PG8_STAGE(bufoff, gbase, voff) do { _Pragma("unroll") for (int _i = 0; _i < 2; ++_i) \
        __builtin_amdgcn_global_load_lds((const unsigned*)((const char*)(gbase) + (voff)[_i]), (PG8_LAS unsigned*)(lds + (bufoff) + ldsw + _i * 8192), 16, 0, 0); } while (0)
#define PG8_LDA(dst, b, h) do { _Pragma("unroll") for (int m = 0; m < 4; ++m) _Pragma("unroll") for (int k = 0; k < 2; ++k) dst[m][k] = *(const PG8_LAS bf16x8*)(lds + PG8_SA(b, h) + aoff + m * 2048 + k * 1024); } while (0)
#define PG8_LDB(dst, b, h) do { _Pragma("unroll") for (int n = 0; n < 2; ++n) _Pragma("unroll") for (int k = 0; k < 2; ++k) dst[n][k] = *(const PG8_LAS bf16x8*)(lds + PG8_SB(b, h) + boff + n * 2048 + k * 1024); } while (0)
#define PG8_MMA(ai, bj, At, Bt) do { __builtin_amdgcn_s_setprio(1); _Pragma("unroll") for (int m = 0; m < 4; ++m) _Pragma("unroll") for (int n = 0; n < 2; ++n) _Pragma("unroll") for (int k = 0; k < 2; ++k) \
        acc[ai][bj][m][n] = __builtin_amdgcn_mfma_f32_16x16x32_bf16(Bt[n][k], At[m][k], acc[ai][bj][m][n], 0, 0, 0); __builtin_amdgcn_s_setprio(0); } while (0)
#define PG8_WAIT_V(n) asm volatile("s_waitcnt vmcnt(" #n ")" ::: "memory")
#define PG8_WAIT_L(n) asm volatile("s_waitcnt lgkmcnt(" #n ")" ::: "memory")
#define PG8_BAR __builtin_amdgcn_s_barrier()
#define PG8_SCHED __builtin_amdgcn_sched_barrier(0)
    Unit cur, nxt; int ui = 0;
    if (!S.next(0, cur)) return;
    f32x4 acc[2][2][4][2];
#pragma unroll
    for (int a = 0; a < 2; ++a)
#pragma unroll
        for (int b = 0; b < 2; ++b)
#pragma unroll
            for (int m = 0; m < 4; ++m)
#pragma unroll
                for (int n = 0; n < 2; ++n) acc[a][b][m][n] = (f32x4){0.f, 0.f, 0.f, 0.f};
    bf16x8 At[4][2], B0[2][2], B1[2][2];
    const char* cA = (const char*)g.A + (size_t)cur.pm * tstep; const char* cB = (const char*)g.Bt + (size_t)cur.pn * tstepB;
    S.a_ready(cur);
    if constexpr (SP2) {
        PG8_STAGE(PG8_SB(0, 0), cB, voffB); PG8_STAGE(PG8_SB(0, 1), cB + hstepB, voffB); PG8_STAGE(PG8_SA(0, 0), cA, voffA); PG8_STAGE(PG8_SA(0, 1), cA + hstep, voffA);
        if (wr == 1) PG8_BAR;
        PG8_WAIT_V(2); PG8_BAR;
        PG8_STAGE(PG8_SB(1, 0), cB + kstep, voffB); PG8_STAGE(PG8_SA(1, 0), cA + kstep, voffA); PG8_STAGE(PG8_SB(1, 1), cB + hstepB + kstep, voffB);
        PG8_WAIT_V(6); PG8_BAR;
    } else {
        PG8_STAGE(PG8_SB(0, 0), cB, voffB); PG8_STAGE(PG8_SA(0, 0), cA, voffA); PG8_STAGE(PG8_SB(0, 1), cB + hstepB, voffB); PG8_STAGE(PG8_SA(0, 1), cA + hstep, voffA);
        if (wr == 1) PG8_BAR;
        PG8_WAIT_V(4); PG8_BAR;
        PG8_STAGE(PG8_SB(1, 0), cB + kstep, voffB); PG8_STAGE(PG8_SA(1, 0), cA + kstep, voffA); PG8_STAGE(PG8_SB(1, 1), cB + hstepB + kstep, voffB);
        PG8_WAIT_V(6); PG8_BAR;
    }
    for (;;) {
        const bool has_next = S.next(ui + 1, nxt);
        const char* nA = has_next ? (const char*)g.A + (size_t)nxt.pm * tstep : cA; const char* nB = has_next ? (const char*)g.Bt + (size_t)nxt.pn * tstepB : cB;
        for (int t = 0; t < nt; t += 2) {
            const bool last = (t == nt - 2);
            const char* a1 = cA + (size_t)(t + 1) * kstep;
            const char* a2 = last ? nA : cA + (size_t)(t + 2) * kstep; const char* b2 = last ? nB : cB + (size_t)(t + 2) * kstep;
            const char* a3 = a2 + kstep; const char* b3 = b2 + kstep;
            if (last && has_next) S.a_ready(nxt);
            if constexpr (SP2) {
            PG8_LDB(B0, 0, 0); PG8_LDB(B1, 0, 1); PG8_SCHED; PG8_LDA(At, 0, 0); PG8_STAGE(PG8_SA(1, 1), a1 + hstep, voffA);
            PG8_WAIT_V(8); PG8_WAIT_L(0); PG8_BAR; PG8_MMA(0, 0, At, B0); PG8_MMA(0, 1, At, B1); PG8_BAR; PG8_SCHED;
            PG8_LDA(At, 0, 1); PG8_STAGE(PG8_SB(0, 0), b2, voffB); PG8_STAGE(PG8_SB(0, 1), b2 + hstepB, voffB); PG8_STAGE(PG8_SA(0, 0), a2, voffA);
            PG8_WAIT_V(8); PG8_WAIT_L(0); PG8_BAR; PG8_MMA(1, 0, At, B0); PG8_MMA(1, 1, At, B1); PG8_BAR; PG8_SCHED;
            PG8_LDB(B0, 1, 0); PG8_LDB(B1, 1, 1); PG8_SCHED; PG8_LDA(At, 1, 0); PG8_STAGE(PG8_SA(0, 1), a2 + hstep, voffA);
            PG8_WAIT_V(8); PG8_WAIT_L(0); PG8_BAR; PG8_MMA(0, 0, At, B0); PG8_MMA(0, 1, At, B1); PG8_BAR; PG8_SCHED;
            PG8_LDA(At, 1, 1); PG8_STAGE(PG8_SB(1, 0), b3, voffB); PG8_STAGE(PG8_SB(1, 1), b3 + hstepB, voffB); PG8_STAGE(PG8_SA(1, 0), a3, voffA);
            PG8_WAIT_V(8); PG8_WAIT_L(0); PG8_BAR; PG8_MMA(1, 0, At, B0); PG8_MMA(1, 1, At, B1); PG8_BAR; PG8_SCHED;
            } else {
            PG8_LDB(B0, 0, 0); PG8_SCHED; PG8_LDA(At, 0, 0); PG8_STAGE(PG8_SA(1, 1), a1 + hstep, voffA);
            PG8_WAIT_L(8); PG8_BAR; PG8_WAIT_L(0); PG8_MMA(0, 0, At, B0); PG8_BAR; PG8_SCHED;
            PG8_LDB(B1, 0, 1); PG8_STAGE(PG8_SB(0, 0), b2, voffB);
            PG8_BAR; PG8_WAIT_L(0); PG8_MMA(0, 1, At, B1); PG8_BAR;
            PG8_LDA(At, 0, 1); PG8_STAGE(PG8_SA(0, 0), a2, voffA);
            PG8_BAR; PG8_WAIT_L(0); PG8_MMA(1, 0, At, B0); PG8_BAR; PG8_SCHED;
            PG8_STAGE(PG8_SB(0, 1), b2 + hstepB, voffB);
            PG8_WAIT_V(6); PG8_BAR; PG8_MMA(1, 1, At, B1); PG8_BAR;
            PG8_LDB(B0, 1, 0); PG8_SCHED; PG8_LDA(At, 1, 0); PG8_STAGE(PG8_SA(0, 1), a2 + hstep, voffA);
            PG8_WAIT_L(8); PG8_BAR; PG8_WAIT_L(0); PG8_MMA(0, 0, At, B0); PG8_BAR; PG8_SCHED;
            PG8_LDB(B1, 1, 1); PG8_STAGE(PG8_SB(1, 0), b3, voffB);
            PG8_BAR; PG8_WAIT_L(0); PG8_MMA(0, 1, At, B1); PG8_BAR;
            PG8_LDA(At, 1, 1); PG8_STAGE(PG8_SA(1, 0), a3, voffA);
            PG8_BAR; PG8_WAIT_L(0); PG8_MMA(1, 0, At, B0); PG8_BAR; PG8_SCHED;
            PG8_STAGE(PG8_SB(1, 1), b3 + hstepB, voffB);
            PG8_WAIT_V(6); PG8_BAR; PG8_MMA(1, 1, At, B1); PG8_BAR;
            }
        }
        if constexpr (ALIGN_EPI) { if (wr == 0) PG8_BAR; }
        if constexpr (!Epi::AFTER_DRAIN) { E(acc, cur, wr, wc, fr, fq); S.done(cur); }
        if (!has_next) break;
#pragma unroll
        for (int a = 0; a < 2; ++a)
#pragma unroll
            for (int b = 0; b < 2; ++b)
#pragma unroll
                for (int m = 0; m < 4; ++m)
#pragma unroll
                    for (int n = 0; n < 2; ++n) acc[a][b][m][n] = (f32x4){0.f, 0.f, 0.f, 0.f};
        cur = nxt; cA = nA; cB = nB; ++ui;
        if constexpr (ALIGN_EPI) { if (wr == 1) PG8_BAR; }
    }
    PG8_WAIT_V(0);
    if constexpr (!ALIGN_EPI) { if (wr == 0) PG8_BAR; }
    PG8_BAR;
    if constexpr (Epi::AFTER_DRAIN) { E.fused(acc, cur, wr, wc, fr, fq, lds, wid, lane); S.done(cur); }
#undef PG8_SA
#undef PG8_SB
#undef PG8_STAGE
#undef PG8_LDA
#undef PG8_LDB
#undef PG8_MMA
#undef PG8_WAIT_V
#undef PG8_WAIT_L
#undef PG8_BAR
#undef PG8_SCHED
}
}

typedef unsigned short bf16_t;
typedef short bf16x8 __attribute__((ext_vector_type(8)));
typedef short s16x4 __attribute__((ext_vector_type(4)));
typedef float f32x4 __attribute__((ext_vector_type(4)));
typedef float f32x16 __attribute__((ext_vector_type(16)));
typedef unsigned u32x4 __attribute__((ext_vector_type(4)));
typedef unsigned u32x2 __attribute__((ext_vector_type(2)));
#define LAS __attribute__((address_space(3)))

constexpr int DM = 2048, SEQ = 16384, NMETA = 16, LTOK = SEQ + NMETA, MP = 16640, DFF = 8192;
constexpr int NIN_SRC = 6160, NIN = 6400, PW = 6144;
constexpr int NCH = 257;
constexpr int CFP = 16896;
constexpr float ALPHA = 1.4142135623730951f;
constexpr float LN_EPS = 1e-5f, RMS_EPS = 1e-6f;
constexpr int C_MQ = 0, C_MK = 512, C_MV = 1024, C_MO = 2048, C_FQ = 3072, C_FK = 4096, C_FV = 5120;

constexpr size_t MiB = 1u << 20;
constexpr size_t WS_CTL = 0, WS_ZS = 0x20000, WS_GM = 0x60000, WS_MPREV = 0x70000, WS_NLOC = 0x100000, WS_CF = 0x200000, WS_GATES = 0x300000;
constexpr int LDU = DM + 64, LDD = DFF + 64;
constexpr size_t WS_WIN = 8 * MiB, WS_WUP = 33 * MiB, WS_WDOWN = 66 * MiB, WS_WOUT = 495 * MiB;
constexpr size_t WS_HB = 105 * MiB, WS_MIX = 170 * MiB, WS_PROJ = 235 * MiB, WS_CT = 430 * MiB, WS_U = 235 * MiB, WS_Z1 = 235 * MiB, WS_END = 503 * MiB;
static_assert((size_t)DFF * LDU * 2 <= 33 * MiB && (size_t)DM * LDD * 2 <= 39 * MiB && (size_t)MP * PW * 2 <= 195 * MiB && (size_t)4 * NCH * 32768 * 2 <= 65 * MiB && (size_t)MP * DFF * 2 <= 260 * MiB && (size_t)MP * DM * 4 <= 195 * MiB, "ws map");

constexpr int LDS_BYTES = 139264;
constexpr int LDS_MISC = 138240;

__device__ __forceinline__ unsigned cvt_pk_bf16(float lo, float hi) { unsigned r; asm volatile("v_cvt_pk_bf16_f32 %0, %1, %2" : "=v"(r) : "v"(lo), "v"(hi)); return r; }
__device__ __forceinline__ float bf2f(unsigned short v) { return __uint_as_float(((unsigned)v) << 16); }
__device__ __forceinline__ float bflo(unsigned w) { return __uint_as_float(w << 16); }
__device__ __forceinline__ float bfhi(unsigned w) { return __uint_as_float(w & 0xffff0000u); }
__device__ __forceinline__ float fast_exp(float x) { return __builtin_amdgcn_exp2f(x * 1.4426950408889634f); }
__device__ __forceinline__ float logsigmoid(float x) { return fminf(x, 0.f) - log1pf(__expf(-fabsf(x))); }
__device__ __forceinline__ float sigmoidf(float x) { return 1.f / (1.f + __expf(-x)); }

struct Params {
    const float* in[17];
    float* out; unsigned char* ws;
    int ph_lo, ph_hi;
};

struct EpiProj {
    static constexpr bool PERM = true, AFTER_DRAIN = false;
    bf16_t* O;
    __device__ __forceinline__ void operator()(const pg8::f32x4 (&acc)[2][2][4][2], const pg8::Unit& u, int wr, int wc, int fr, int fq) const {
        const int row0 = NMETA + u.pm * 256 + wr * 64 + fr, col0 = u.pn * 256 + wc * 32 + 8 * fq;
#pragma unroll
        for (int ai = 0; ai < 2; ++ai)
#pragma unroll
            for (int m = 0; m < 4; ++m) { bf16_t* rowp = O + (size_t)(row0 + ai * 128 + m * 16) * PW + col0;
#pragma unroll
                for (int bj = 0; bj < 2; ++bj) { const pg8::f32x4 v0 = acc[ai][bj][m][0], v1 = acc[ai][bj][m][1];
                    u32x4 w; w.x = cvt_pk_bf16(v0[0], v0[1]); w.y = cvt_pk_bf16(v0[2], v0[3]); w.z = cvt_pk_bf16(v1[0], v1[1]); w.w = cvt_pk_bf16(v1[2], v1[3]);
                    *(u32x4*)(rowp + bj * 128) = w; } }
    }
};
struct EpiSqRelu {
    static constexpr bool PERM = true, AFTER_DRAIN = false;
    bf16_t* O;
    __device__ __forceinline__ void operator()(const pg8::f32x4 (&acc)[2][2][4][2], const pg8::Unit& u, int wr, int wc, int fr, int fq) const {
        const int row0 = NMETA + u.pm * 256 + wr * 64 + fr, col0 = u.pn * 256 + wc * 32 + 8 * fq;
#pragma unroll
        for (int ai = 0; ai < 2; ++ai)
#pragma unroll
            for (int m = 0; m < 4; ++m) { bf16_t* rowp = O + (size_t)(row0 + ai * 128 + m * 16) * DFF + col0;
#pragma unroll
                for (int bj = 0; bj < 2; ++bj) { pg8::f32x4 v0 = acc[ai][bj][m][0], v1 = acc[ai][bj][m][1];
#pragma unroll
                    for (int i = 0; i < 4; ++i) { const float a = fmaxf(v0[i], 0.f), b = fmaxf(v1[i], 0.f); v0[i] = a * a; v1[i] = b * b; }
                    u32x4 w; w.x = cvt_pk_bf16(v0[0], v0[1]); w.y = cvt_pk_bf16(v0[2], v0[3]); w.z = cvt_pk_bf16(v1[0], v1[1]); w.w = cvt_pk_bf16(v1[2], v1[3]);
                    *(u32x4*)(rowp + bj * 128) = w; } }
    }
};
template <int MODE> struct EpiRes {
    static constexpr bool PERM = true, AFTER_DRAIN = false;
    const bf16_t* H; float* Z;
    __device__ __forceinline__ void operator()(const pg8::f32x4 (&acc)[2][2][4][2], const pg8::Unit& u, int wr, int wc, int fr, int fq) const {
        const int row0 = u.pm * 256 + wr * 64 + fr, col0 = u.pn * 256 + wc * 32 + 8 * fq;
#pragma unroll
        for (int ai = 0; ai < 2; ++ai)
#pragma unroll
            for (int m = 0; m < 4; ++m) { const int row = row0 + ai * 128 + m * 16;
                float* zr = Z + (size_t)(row + (MODE == 0 ? NMETA : 0)) * DM;
                const bf16_t* hr = H + (size_t)(row + NMETA) * DM;
#pragma unroll
                for (int bj = 0; bj < 2; ++bj) { const int c = col0 + bj * 128; const u32x4 hw = *(const u32x4*)(hr + c);
                    pg8::f32x4 a0 = acc[ai][bj][m][0], a1 = acc[ai][bj][m][1];
                    a0[0] += ALPHA * bflo(hw.x); a0[1] += ALPHA * bfhi(hw.x); a0[2] += ALPHA * bflo(hw.y); a0[3] += ALPHA * bfhi(hw.y);
                    a1[0] += ALPHA * bflo(hw.z); a1[1] += ALPHA * bfhi(hw.z); a1[2] += ALPHA * bflo(hw.w); a1[3] += ALPHA * bfhi(hw.w);
                    *(pg8::f32x4*)(zr + c) = a0; *(pg8::f32x4*)(zr + c + 4) = a1; } }
    }
};

template <int KSPLIT, class Epi>
__device__ __forceinline__ void skinny_gemm(const bf16_t* __restrict__ A, int lda, const bf16_t* __restrict__ Wt, int ldw, int K, int ntiles, char* lds, const Epi& E) {
    int tidl_ = threadIdx.x; asm volatile("" : "+v"(tidl_));
    const int tid = tidl_, wid = __builtin_amdgcn_readfirstlane(tid >> 6), lane = tid & 63, i = lane & 15, kq = lane >> 4;
    const int total = ntiles * KSPLIT, klen = K / KSPLIT;
    for (int base = 0; base < total; base += (int)gridDim.x * 8) {
        const int slot = base + (int)blockIdx.x * 8 + wid, tile = slot / KSPLIT, ks = slot % KSPLIT;
        const bool act = slot < total;
        f32x4 acc = {0.f, 0.f, 0.f, 0.f};
        if (act) {
            const bf16_t* ap = A + (size_t)i * lda + ks * klen + 8 * kq;
            const bf16_t* wp = Wt + (size_t)(tile * 16 + i) * ldw + ks * klen + 8 * kq;
            for (int k = 0; k < klen; k += 256) {
                bf16x8 a[8], w[8];
#pragma unroll
                for (int j = 0; j < 8; ++j) { a[j] = *(const bf16x8*)(ap + k + 32 * j); w[j] = *(const bf16x8*)(wp + k + 32 * j); }
#pragma unroll
                for (int j = 0; j < 8; ++j) acc = __builtin_amdgcn_mfma_f32_16x16x32_bf16(w[j], a[j], acc, 0, 0, 0);
            }
        }
        if (KSPLIT > 1) {
            float* red = (float*)lds;
            if (act) *(f32x4*)(red + wid * 256 + lane * 4) = acc;
            __syncthreads();
            if (act && ks == 0) {
#pragma unroll
                for (int j = 1; j < KSPLIT; ++j) acc += *(const f32x4*)(red + (wid + j) * 256 + lane * 4); }
            __syncthreads();
        }
        if (act && ks == 0) E(tile, i, kq, acc);
    }
}
struct SkProj { bf16_t* O; __device__ __forceinline__ void operator()(int tile, int j, int q, f32x4 a) const {
    u32x2 w; w.x = cvt_pk_bf16(a[0], a[1]); w.y = cvt_pk_bf16(a[2], a[3]); *(u32x2*)(O + (size_t)j * PW + tile * 16 + 4 * q) = w; } };
struct SkGates { float* G; __device__ __forceinline__ void operator()(int tile, int j, int q, f32x4 a) const {
    float* g = G + (size_t)(tile * 16 + 4 * q) * 16 + j; g[0] = a[0]; g[16] = a[1]; g[32] = a[2]; g[48] = a[3]; } };
struct SkSqRelu { bf16_t* O; __device__ __forceinline__ void operator()(int tile, int j, int q, f32x4 a) const {
#pragma unroll
    for (int c = 0; c < 4; ++c) { const float r = fmaxf(a[c], 0.f); a[c] = r * r; }
    u32x2 w; w.x = cvt_pk_bf16(a[0], a[1]); w.y = cvt_pk_bf16(a[2], a[3]); *(u32x2*)(O + (size_t)j * DFF + tile * 16 + 4 * q) = w; } };
struct SkRes { const bf16_t* H; float* Z; __device__ __forceinline__ void operator()(int tile, int j, int q, f32x4 a) const {
    const int c = tile * 16 + 4 * q; const u32x2 hw = *(const u32x2*)(H + (size_t)j * DM + c);
    a[0] += ALPHA * bflo(hw.x); a[1] += ALPHA * bfhi(hw.x); a[2] += ALPHA * bflo(hw.y); a[3] += ALPHA * bfhi(hw.y);
    *(f32x4*)(Z + (size_t)j * DM + c) = a; } };

namespace fox {
constexpr int D = 128, NW = 8, QBLK = 32, KVBLK = 64, QB = 256;
constexpr int SHM_V = KVBLK * D * 2, SHM_K = KVBLK * D * 2;
constexpr int L_WS = 2 * SHM_V + 2 * SHM_K, L_BIAS = L_WS + NW * 64 * 4;
constexpr int SKV = 16448;
constexpr int NQB = 65, NHEAD = 8;
constexpr float SCALE = 0.08838834764831845f, INV_SCALE = 11.313708498984761f;
constexpr float THR = 8.f;
constexpr unsigned WBIG = 1u << 30;
constexpr float TSKIP = 30.f;
static_assert(L_BIAS + (SKV + 256) * 4 <= LDS_MISC, "attention LDS");

#define KSWZ(row, colB) ((row) * 256 + ((colB) ^ (((row) & 7) << 4)))
#define SBAR() __builtin_amdgcn_sched_barrier(0)
__device__ __forceinline__ int v_st(int k, int c) { const int kk = (k & ~0xC) | ((k & 4) << 1) | ((k & 8) >> 1); return ((kk >> 3) * 4 + (c >> 5)) * 512 + ((kk & 7) * 32 + (c & 31)) * 2; }
__device__ __forceinline__ int v_rd_base(int lane) { return ((lane & 3) << 3) | (((lane >> 2) & 3) << 6) | (((lane >> 4) & 1) << 5) | (((lane >> 5) & 1) << 8); }
constexpr int v_rd_off(int d0, int ks, int half) { return d0 * 512 + ks * 4096 + half * 2048; }
__device__ __forceinline__ int crow(int r, int hi) { return (r & 3) + 8 * (r >> 2) + 4 * hi; }
__device__ __forceinline__ bf16x8 load8(const bf16_t* p) { return *reinterpret_cast<const bf16x8*>(p); }
__device__ __forceinline__ void mask_tile(f32x16& p0, f32x16& p1, int dq, unsigned W) {
    const float NEG = -__builtin_inff();
#pragma unroll
    for (int r = 0; r < 16; ++r) {
        const int c = (r & 3) + 8 * (r >> 2);
        if ((unsigned)(dq - c) >= W) p0[r] = NEG;
        if ((unsigned)(dq - c - 32) >= W) p1[r] = NEG;
    }
}
__device__ __forceinline__ void partialSM(f32x16& p0, f32x16& p1, float& m_reg, float& mn, float& alpha) {
    float pmax = p0[0];
#pragma unroll
    for (int r = 1; r < 16; ++r) pmax = fmaxf(pmax, p0[r]);
#pragma unroll
    for (int r = 0; r < 16; ++r) pmax = fmaxf(pmax, p1[r]);
    { auto rr = __builtin_amdgcn_permlane32_swap(__float_as_uint(pmax), __float_as_uint(pmax), false, false);
      pmax = fmaxf(__uint_as_float(rr[0]), __uint_as_float(rr[1])); }
    constexpr float C2 = 1.4426950408889634f * SCALE;
    if (__builtin_expect(__all((pmax - m_reg) * SCALE <= THR), 1)) { mn = m_reg; alpha = 1.f; }
    else { mn = fmaxf(m_reg, pmax); alpha = __builtin_amdgcn_exp2f((m_reg - mn) * C2); m_reg = mn; }
    const float mnL = -mn * C2;
#pragma unroll
    for (int r = 0; r < 16; ++r) p0[r] = fmaf(p0[r], C2, mnL);
#pragma unroll
    for (int r = 0; r < 16; ++r) p1[r] = fmaf(p1[r], C2, mnL);
#pragma unroll
    for (int r = 0; r < 16; ++r) p0[r] = __builtin_amdgcn_exp2f(p0[r]);
}
__device__ __forceinline__ void finishSM(f32x16& p0, f32x16& p1, float alpha, float& l_reg, bf16x8& pa0, bf16x8& pa1, bf16x8& pa2, bf16x8& pa3) {
#pragma unroll
    for (int r = 0; r < 16; ++r) p1[r] = __builtin_amdgcn_exp2f(p1[r]);
    float ps = 0;
#pragma unroll
    for (int r = 0; r < 16; ++r) ps += p0[r];
#pragma unroll
    for (int r = 0; r < 16; ++r) ps += p1[r];
    { auto rr = __builtin_amdgcn_permlane32_swap(__float_as_uint(ps), __float_as_uint(ps), false, false);
      ps = __uint_as_float(rr[0]) + __uint_as_float(rr[1]); }
    l_reg = l_reg * alpha + ps;
#define PK4(P, B_, OUT) do { unsigned a0 = cvt_pk_bf16(P[B_+0], P[B_+1]), a1 = cvt_pk_bf16(P[B_+2], P[B_+3]);                          \
        unsigned b0 = cvt_pk_bf16(P[B_+4], P[B_+5]), b1 = cvt_pk_bf16(P[B_+6], P[B_+7]);                                             \
        auto r0 = __builtin_amdgcn_permlane32_swap(a0, b0, false, false); auto r1 = __builtin_amdgcn_permlane32_swap(a1, b1, false, false); \
        u32x4 w = {r0[0], r1[0], r0[1], r1[1]}; OUT = *reinterpret_cast<bf16x8*>(&w); } while (0)
    PK4(p0, 0, pa0); PK4(p0, 8, pa1); PK4(p1, 0, pa2); PK4(p1, 8, pa3);
#undef PK4
}
template <int KB>
__device__ __forceinline__ void qkt(f32x16& p0, f32x16& p1, const char* K_lds, int r32, int hi, const bf16x8* qr, const float* btile) {
#pragma unroll
    for (int j = 0; j < 4; ++j) { const f32x4 a = *(const f32x4*)(btile + 8 * j), b = *(const f32x4*)(btile + 32 + 8 * j);
        p0[4 * j] = a[0]; p0[4 * j + 1] = a[1]; p0[4 * j + 2] = a[2]; p0[4 * j + 3] = a[3];
        p1[4 * j] = b[0]; p1[4 * j + 1] = b[1]; p1[4 * j + 2] = b[2]; p1[4 * j + 3] = b[3]; }
    const char* kb[4];
#pragma unroll
    for (int dd = 0; dd < 4; ++dd) kb[dd] = K_lds + KB * SHM_K + KSWZ(r32, (dd * 16 + hi * 8) * 2);
#pragma unroll
    for (int d0 = 0; d0 < 8; ++d0) { const char* a = kb[d0 & 3] + (d0 >> 2) * 128;
        bf16x8 b0 = *reinterpret_cast<const bf16x8*>(a);
        bf16x8 b1 = *reinterpret_cast<const bf16x8*>(a + 32 * 256);
        p0 = __builtin_amdgcn_mfma_f32_32x32x16_bf16(b0, qr[d0], p0, 0, 0, 0);
        p1 = __builtin_amdgcn_mfma_f32_32x32x16_bf16(b1, qr[d0], p1, 0, 0, 0); }
}
template <int VB>
__device__ __forceinline__ void pv_tile(f32x16* o, int vb0, bf16x8 pa0, bf16x8 pa1, bf16x8 pa2, bf16x8 pa3) {
#define TRRD(dst, off) asm volatile("ds_read_b64_tr_b16 %0, %1 offset:%2" : "=&v"(dst) : "v"(vb0), "i"(off) : "memory")
#define PV_D0(d0) do { s16x4 l0, l1, l2, l3, h0, h1, h2, h3; constexpr int b_ = VB * SHM_V + v_rd_off(d0, 0, 0); \
        TRRD(l0, b_); TRRD(h0, b_ + 2048); TRRD(l1, b_ + 4096); TRRD(h1, b_ + 6144); TRRD(l2, b_ + 8192); TRRD(h2, b_ + 10240); TRRD(l3, b_ + 12288); TRRD(h3, b_ + 14336); \
        asm volatile("s_waitcnt lgkmcnt(0)" ::: "memory"); SBAR();   \
        o[d0] = __builtin_amdgcn_mfma_f32_32x32x16_bf16(pa0, (bf16x8){l0[0], l0[1], l0[2], l0[3], h0[0], h0[1], h0[2], h0[3]}, o[d0], 0, 0, 0);   \
        o[d0] = __builtin_amdgcn_mfma_f32_32x32x16_bf16(pa1, (bf16x8){l1[0], l1[1], l1[2], l1[3], h1[0], h1[1], h1[2], h1[3]}, o[d0], 0, 0, 0);   \
        o[d0] = __builtin_amdgcn_mfma_f32_32x32x16_bf16(pa2, (bf16x8){l2[0], l2[1], l2[2], l2[3], h2[0], h2[1], h2[2], h2[3]}, o[d0], 0, 0, 0);   \
        o[d0] = __builtin_amdgcn_mfma_f32_32x32x16_bf16(pa3, (bf16x8){l3[0], l3[1], l3[2], l3[3], h3[0], h3[1], h3[2], h3[3]}, o[d0], 0, 0, 0); } while (0)
    PV_D0(0); PV_D0(1); PV_D0(2); PV_D0(3);
#undef PV_D0
#undef TRRD
}
struct BlockRef { const bf16_t* Q; const bf16_t* K; bf16_t* O; int P0; int head; int jlo; };
constexpr int VOFF = C_FV - C_FK;
struct Seam { bf16x8 qr[8]; bf16x8 st_v0, st_v1, st_k0, st_k1; };
#define VMW() asm volatile("s_waitcnt vmcnt(0)" ::: "memory")
#define VMWN(n) asm volatile("s_waitcnt vmcnt(%0)" :: "i"(n) : "memory")
#define SLOAD_H(Kp, k0) do { const bf16_t* kb__ = (Kp) + (size_t)(k0) * PW;     \
                         S.st_v0 = load8(kb__ + voff0 + VOFF); S.st_v1 = load8(kb__ + voff1 + VOFF);              \
                         S.st_k0 = load8(kb__ + voff0); S.st_k1 = load8(kb__ + voff1); } while (0)
#define SWRITE_HK(bf) do { *(bf16x8*)(K_lds + (bf) * SHM_K + kws) = S.st_k0; *(bf16x8*)(K_lds + (bf) * SHM_K + kws + 32 * 256) = S.st_k1; } while (0)
#define SWRITE_HV(bf) do { *(bf16x8*)(V_lds + (bf) * SHM_V + vst0) = S.st_v0; *(bf16x8*)(V_lds + (bf) * SHM_V + vst1) = S.st_v1; } while (0)
#define SWRITE_H(bf) do { SWRITE_HV(bf); SWRITE_HK(bf); } while (0)
__device__ __forceinline__ void fox_prime(const BlockRef& cur, char* lds, Seam& S) {
    int tidl_ = threadIdx.x; asm volatile("" : "+v"(tidl_));
    const int tid = tidl_, wid = __builtin_amdgcn_readfirstlane(tid >> 6), lane = tid & 63, r32 = lane & 31, hi = lane >> 5;
    const int sr = tid >> 4, sc = (tid & 15) * 8, kws = KSWZ(sr, sc * 2); char* K_lds = lds + 2 * SHM_V;
    const unsigned voff0 = (unsigned)(sr * PW + sc), voff1 = voff0 + 32u * PW, voffq = (unsigned)(r32 * PW + hi * 8);
    { const bf16_t* qb__ = cur.Q + (size_t)(wid * QBLK) * PW;
#pragma unroll
    for (int d0 = 0; d0 < 8; ++d0) S.qr[d0] = load8(qb__ + voffq + d0 * 16); }
    SLOAD_H(cur.K, cur.jlo * KVBLK); VMW(); SWRITE_HK(0);
    __syncthreads();
}
__device__ __forceinline__ int fox_take(unsigned* ctr, int xcc) {
    for (int hh = 0; hh <= NHEAD; ++hh) { const int hd = hh == 0 ? xcc : NHEAD - hh;
        if (hh && hd == xcc) continue;
        if (__hip_atomic_load(ctr + hd, __ATOMIC_RELAXED, __HIP_MEMORY_SCOPE_AGENT) >= (unsigned)NQB) continue;
        const unsigned i = atomicAdd(ctr + hd, 1u); if (i < (unsigned)NQB) return hd * 256 + (NQB - 1 - (int)i); }
    return -1;
}
__device__ __forceinline__ int fox_jlo(const float* __restrict__ CF, const unsigned* __restrict__ nrm, int head, int P0) {
    int zv = 0; asm volatile("" : "+v"(zv));
    const float* cf = CF + (size_t)head * CFP;
    const int dk = (int)nrm[128 + head * 80 + (P0 >> 8) + zv]; const float dmin = __uint_as_float((unsigned)(dk ^ ((dk >> 31) & 0x7fffffff)));
    const float B = sqrtf(__uint_as_float(nrm[head * 2 + zv]) * __uint_as_float(nrm[head * 2 + 1 + zv])) * SCALE + TSKIP - dmin;
    const float thr = cf[P0 + zv] + B;
    int jh = (P0 + QB - 1) / KVBLK + 1; if (jh > SKV / KVBLK) jh = SKV / KVBLK;
    const int j = threadIdx.x;
    const int flag = (j < jh) && (cf[64 * j + 63] > thr);
    return __builtin_amdgcn_readfirstlane(__syncthreads_count(flag));
}
__device__ __forceinline__ void fox_ref(int code, BlockRef& R, bf16_t* PROJ, bf16_t* MIX) {
    const int qb = code & 255, hd = code >> 8; R.P0 = qb * 256; R.head = hd; R.Q = PROJ + (size_t)R.P0 * PW + C_FQ + hd * 128;
    R.K = PROJ + C_FK + hd * 128; R.O = MIX + (size_t)R.P0 * DM + 1024 + hd * 128;
}
__device__ __forceinline__ bool fox_block(const BlockRef& cur, BlockRef& nxt, unsigned* ctr, const unsigned* nrm, bf16_t* PROJ, bf16_t* MIX, char* lds, Seam& S, const float* __restrict__ CF, const float* __restrict__ fnorm) {
    int tid_ = threadIdx.x; asm volatile("" : "+v"(tid_));
    const int tid = tid_, wid = __builtin_amdgcn_readfirstlane(tid >> 6), lane = tid & 63, r32 = lane & 31, hi = lane >> 5;
    int j_hi = (cur.P0 + QB - 1) / KVBLK + 1; if (j_hi > SKV / KVBLK) j_hi = SKV / KVBLK;
    const int j_lo = cur.jlo, NT = j_hi - j_lo;
    float* bias = (float*)(lds + L_BIAS);
    { const float* cf = CF + (size_t)cur.head * CFP; int zv = 0; asm volatile("" : "+v"(zv)); const float cref = cf[cur.P0 + zv]; const int nk = NT * KVBLK; const float* cfl = cf + j_lo * KVBLK;
      for (int s = tid; s < nk; s += 512) bias[s] = (cref - cfl[s]) * INV_SCALE;
      __syncthreads(); }
    const float* bt = bias + 4 * hi;
    const int qlo = cur.P0 + wid * QBLK, qm = qlo + r32 - 4 * hi;
    char* V_lds = lds; char* K_lds = lds + 2 * SHM_V;
    float* ws = (float*)(lds + L_WS) + wid * 64; float* li_l = ws, * al_l = ws + 32;
    float m_reg = -1e30f, l_reg = 0; f32x16 o[4] = {};
    const int sr = tid >> 4, sc = (tid & 15) * 8, vst0 = v_st(sr, sc), vst1 = v_st(32 + sr, sc), kws = KSWZ(sr, sc * 2);
    const int vb0 = (int)(uintptr_t)V_lds + v_rd_base(lane);
    const bf16_t* Kh = cur.K;
    const unsigned voff0 = (unsigned)(sr * PW + sc), voff1 = voff0 + 32u * PW, voffq = (unsigned)(r32 * PW + hi * 8);
#define RESC(a) do { if (__any((a) < 1.f)) { if (hi == 0) al_l[r32] = (a); asm volatile("s_waitcnt lgkmcnt(0)" ::: "memory");              \
                     _Pragma("unroll") for (int d_ = 0; d_ < 4; ++d_) _Pragma("unroll") for (int r = 0; r < 16; ++r) o[d_][r] *= al_l[crow(r, hi)]; } } while (0)
#define KBASE(t) ((j_lo + (t)) * KVBLK)
#define MASKT(P0_, P1_, t) do { const int kb_ = KBASE(t); if (kb_ + KVBLK - 1 > qlo) mask_tile(P0_, P1_, qm - kb_, WBIG); } while (0)
#define SEAM_K0() do { VMWN(8); SWRITE_HK(0); SBAR(); } while (0)
    f32x16 pA0, pA1, pB0, pB1; float mnA, mnB, alA, alB; bf16x8 pa0, pa1, pa2, pa3;
    SWRITE_HV(0); SBAR();
    if (NT > 1) SLOAD_H(Kh, KBASE(1));
    SBAR(); qkt<0>(pA0, pA1, K_lds, r32, hi, S.qr, bt);
    MASKT(pA0, pA1, 0); partialSM(pA0, pA1, m_reg, mnA, alA);
    if (NT > 1) { VMW(); SWRITE_H(1); }
    __syncthreads();
#define HALF_STEP(PX0, PX1, mnX, alX, PY0, PY1, alY, t, KB, VB, SB) do {                                                      \
        SBAR(); qkt<KB>(PX0, PX1, K_lds, r32, hi, S.qr, bt + (t) * KVBLK);                                                       \
        finishSM(PY0, PY1, alY, l_reg, pa0, pa1, pa2, pa3); SBAR();                                                           \
        if ((t) + 1 < NT) { SLOAD_H(Kh, KBASE((t) + 1)); SBAR(); }                                                        \
        pv_tile<VB>(o, vb0, pa0, pa1, pa2, pa3); MASKT(PX0, PX1, (t)); partialSM(PX0, PX1, m_reg, mnX, alX);                  \
        __syncthreads();                                                                                                      \
        if ((t) + 1 < NT) { VMW(); SWRITE_H(SB); }                                                                            \
        RESC(alX); __syncthreads(); } while (0)
    for (int t = 1; t + 1 < NT; t += 2) {
        HALF_STEP(pB0, pB1, mnB, alB, pA0, pA1, alA, t, 1, 0, 0);
        HALF_STEP(pA0, pA1, mnA, alA, pB0, pB1, alB, t + 1, 0, 1, 1);
    }
    const bool even = (NT & 1) == 0;
    if (even) { SBAR(); qkt<1>(pB0, pB1, K_lds, r32, hi, S.qr, bt + (NT - 1) * KVBLK); SBAR(); }
    bool more;
    { volatile int* slot = (volatile int*)(lds + LDS_MISC);
      if (tid == 0) { const unsigned i_ = atomicAdd(ctr + cur.head, 1u); *slot = i_ < (unsigned)NQB ? cur.head * 256 + (NQB - 1 - (int)i_) : -1; }
      __syncthreads();
      const int ni = __builtin_amdgcn_readfirstlane(*slot);
      more = ni >= 0;
      if (more) { fox_ref(ni, nxt, PROJ, MIX); nxt.jlo = fox_jlo(CF, nrm, nxt.head, nxt.P0); } else nxt = cur; }
    SLOAD_H(nxt.K, nxt.jlo * KVBLK); SBAR();
    { const bf16_t* qb__ = nxt.Q + (size_t)(wid * QBLK) * PW;
#pragma unroll
    for (int d0 = 0; d0 < 8; ++d0) S.qr[d0] = load8(qb__ + voffq + d0 * 16); }
    SBAR();
    finishSM(pA0, pA1, alA, l_reg, pa0, pa1, pa2, pa3); SBAR();
    pv_tile<0>(o, vb0, pa0, pa1, pa2, pa3);
    if (even) { MASKT(pB0, pB1, NT - 1); partialSM(pB0, pB1, m_reg, mnB, alB); __syncthreads(); RESC(alB);
        finishSM(pB0, pB1, alB, l_reg, pa0, pa1, pa2, pa3); SBAR(); pv_tile<1>(o, vb0, pa0, pa1, pa2, pa3); }
    SBAR(); SEAM_K0();
    if (hi == 0) li_l[r32] = l_reg; asm volatile("s_waitcnt lgkmcnt(0)" ::: "memory");
    float rs[16];
#pragma unroll
    for (int r = 0; r < 16; ++r) { const float rl = __builtin_amdgcn_rcpf(li_l[crow(r, hi)]); float a = 0.f;
#pragma unroll
        for (int d0 = 0; d0 < 4; ++d0) { const float v = o[d0][r] * rl; o[d0][r] = v; a += v * v; }
        a += __shfl_xor(a, 1); a += __shfl_xor(a, 2); a += __shfl_xor(a, 4); a += __shfl_xor(a, 8); a += __shfl_xor(a, 16);
        rs[r] = rsqrtf(a * (1.f / 128.f) + RMS_EPS); }
    float gn[4];
#pragma unroll
    for (int d0 = 0; d0 < 4; ++d0) gn[d0] = fnorm[cur.head * 128 + d0 * 32 + r32];
    bf16_t* Ow = cur.O + (size_t)(wid * QBLK) * DM;
#pragma unroll
    for (int r = 0; r < 16; ++r) { const int orow = crow(r, hi);
#pragma unroll
        for (int d0 = 0; d0 < 4; ++d0) { const float v = o[d0][r] * rs[r] * gn[d0];
            const float vn = __shfl_xor(v, 1);
            if ((r32 & 1) == 0) *(unsigned*)(Ow + (size_t)orow * DM + d0 * 32 + r32) = cvt_pk_bf16(v, vn); } }
    __syncthreads();
    return more;
#undef RESC
#undef KBASE
#undef MASKT
#undef SEAM_K0
#undef HALF_STEP
}
#undef VMW
#undef VMWN
#undef SLOAD_H
#undef SWRITE_HK
#undef SWRITE_HV
#undef SWRITE_H
}

__device__ __forceinline__ float wave_sum(float v) {
#pragma unroll
    for (int o = 1; o < 64; o <<= 1) v += __shfl_xor(v, o);
    return v;
}
__device__ __forceinline__ float wave_max(float v) {
#pragma unroll
    for (int o = 1; o < 64; o <<= 1) v = fmaxf(v, __shfl_xor(v, o));
    return v;
}
__device__ __forceinline__ float wave_scan_add(float x, int lane) {
#pragma unroll
    for (int o = 1; o < 64; o <<= 1) { const float y = __shfl_up(x, o); if (lane >= o) x += y; }
    return x;
}
__device__ __forceinline__ float wave_scan_max(float x, int lane) {
#pragma unroll
    for (int o = 1; o < 64; o <<= 1) { const float y = __shfl_up(x, o); if (lane >= o) x = fmaxf(x, y); }
    return x;
}
__device__ __forceinline__ int fetch_item(unsigned* ctr, char* lds) {
    volatile int* slot = (volatile int*)(lds + LDS_MISC);
    if (threadIdx.x == 0) *slot = (int)atomicAdd(ctr, 1u);
    __syncthreads();
    const int v = __builtin_amdgcn_readfirstlane(*slot);
    __syncthreads();
    return v;
}

__device__ __forceinline__ void signal_done(unsigned* ctr, unsigned n = 1u) {
    asm volatile("s_waitcnt vmcnt(0)" ::: "memory");
    __syncthreads();
    if (threadIdx.x == 0) {
        __builtin_amdgcn_fence(__ATOMIC_RELEASE, "agent");
        asm volatile("s_waitcnt vmcnt(0)" ::: "memory");
        __hip_atomic_fetch_add(ctr, n, __ATOMIC_RELAXED, __HIP_MEMORY_SCOPE_AGENT);
    }
}
__device__ __forceinline__ void wait_count(unsigned* ctr, unsigned want) {
    if (threadIdx.x == 0) {
        unsigned sp = 0;
        while (__hip_atomic_load(ctr, __ATOMIC_RELAXED, __HIP_MEMORY_SCOPE_AGENT) < want) { __builtin_amdgcn_s_sleep(4); if (++sp > (1u << 22)) break; }
        __builtin_amdgcn_fence(__ATOMIC_ACQUIRE, "agent");
        asm volatile("s_waitcnt vmcnt(0)" ::: "memory");
    }
    __syncthreads();
}

__device__ __forceinline__ void transpose_item(const float* __restrict__ W, int K, int N, int nblk, bf16_t* __restrict__ WT, int ldw, int mode, float* scr, int item, int lane) {
    const int kb = item / nblk, nb = item % nblk, k0 = 64 * kb, n0 = 32 * nb;
    const int n = n0 + (lane & 31); int src = n;
    if (mode) src = n < 2048 ? n : (n < 6144 ? n + 8 : (n < 6152 ? n - 6144 + 2048 : (n < 6160 ? n : -1)));
    float wv[32];
#pragma unroll
    for (int i = 0; i < 32; ++i) { const int kk = 2 * i + (lane >> 5); wv[i] = src >= 0 ? W[(size_t)(k0 + kk) * N + src] : 0.f; }
#pragma unroll
    for (int i = 0; i < 32; ++i) { const int kk = 2 * i + (lane >> 5); scr[kk * 33 + (lane & 31)] = wv[i]; }
    asm volatile("s_waitcnt lgkmcnt(0)" ::: "memory");
    const int c = lane & 7;
#pragma unroll
    for (int j = 0; j < 4; ++j) { const int nn = (lane >> 3) + 8 * j; const float* s = scr + (8 * c) * 33 + nn;
        u32x4 o; o.x = cvt_pk_bf16(s[0 * 33], s[1 * 33]); o.y = cvt_pk_bf16(s[2 * 33], s[3 * 33]); o.z = cvt_pk_bf16(s[4 * 33], s[5 * 33]); o.w = cvt_pk_bf16(s[6 * 33], s[7 * 33]);
        *(u32x4*)(WT + (size_t)(n0 + nn) * ldw + k0 + 8 * c) = o; }
    asm volatile("s_waitcnt lgkmcnt(0)" ::: "memory");
}
__device__ __forceinline__ void convert_weights(const Params& P, int l, int part, char* lds, int gw, int NGW, int wid, int lane) {
    float* scr = (float*)(lds + wid * 8704);
    const float* w_in = P.in[2] + (size_t)l * DM * NIN_SRC; const float* w_out = P.in[10] + (size_t)l * DM * DM;
    const float* w_up = P.in[13] + (size_t)l * DM * DFF; const float* w_down = P.in[14] + (size_t)l * DFF * DM;
    bf16_t* WinT = (bf16_t*)(P.ws + WS_WIN); bf16_t* WoutT = (bf16_t*)(P.ws + WS_WOUT); bf16_t* WupT = (bf16_t*)(P.ws + WS_WUP); bf16_t* WdownT = (bf16_t*)(P.ws + WS_WDOWN);
    constexpr int I_IN = (DM / 64) * (NIN / 32), I_OUT = (DM / 64) * (DM / 32), I_UP = (DM / 64) * (DFF / 32), I_DOWN = (DFF / 64) * (DM / 32);
    const int lo = part == 2 ? I_IN + I_OUT : 0, hi = part == 1 ? I_IN + I_OUT : I_IN + I_OUT + I_UP + I_DOWN;
    for (int it = lo + gw; it < hi; it += NGW) {
        int r = it;
        if (r < I_IN) { transpose_item(w_in, DM, NIN_SRC, NIN / 32, WinT, DM, 1, scr, r, lane); continue; } r -= I_IN;
        if (r < I_OUT) { transpose_item(w_out, DM, DM, DM / 32, WoutT, DM, 0, scr, r, lane); continue; } r -= I_OUT;
        if (r < I_UP) { transpose_item(w_up, DM, DFF, DFF / 32, WupT, LDU, 0, scr, r, lane); continue; } r -= I_UP;
        transpose_item(w_down, DFF, DM, DM / 32, WdownT, LDD, 0, scr, r, lane);
    }
}

__device__ __forceinline__ void zero_pad_rows(const Params& P) {
    u32x4* p = (u32x4*)((bf16_t*)(P.ws + WS_PROJ) + (size_t)LTOK * PW); const int n = (MP - LTOK) * PW / 8;
    for (int i = blockIdx.x * 512 + threadIdx.x; i < n; i += gridDim.x * 512) p[i] = (u32x4){0u, 0u, 0u, 0u};
    u32x4* g = (u32x4*)((float*)(P.ws + WS_GATES) + (size_t)LTOK * 16); const int m = (MP - LTOK) * 16 / 4;
    for (int i = blockIdx.x * 512 + threadIdx.x; i < m; i += gridDim.x * 512) g[i] = (u32x4){0u, 0u, 0u, 0u};
}

__device__ __forceinline__ void ln_load(f32x4 (&v)[8], const float* z, int lane) {
#pragma unroll
    for (int j = 0; j < 8; ++j) v[j] = ((const f32x4*)z)[lane + 64 * j];
}
__device__ __forceinline__ void ln_apply(f32x4 (&v)[8], const float* __restrict__ g, const float* __restrict__ b, bf16_t* hb, float* fo, int lane) {
    float s = 0.f;
#pragma unroll
    for (int j = 0; j < 8; ++j) s += (v[j][0] + v[j][1]) + (v[j][2] + v[j][3]);
    const float mean = wave_sum(s) * (1.f / DM); float q = 0.f;
#pragma unroll
    for (int j = 0; j < 8; ++j) { v[j] = v[j] - mean; q += (v[j][0] * v[j][0] + v[j][1] * v[j][1]) + (v[j][2] * v[j][2] + v[j][3] * v[j][3]); }
    const float rstd = rsqrtf(wave_sum(q) * (1.f / DM) + LN_EPS);
#pragma unroll
    for (int j = 0; j < 8; ++j) { const int c = (lane + 64 * j) * 4; const f32x4 gg = *(const f32x4*)(g + c), bb = *(const f32x4*)(b + c);
        const f32x4 y = v[j] * rstd * gg + bb;
        if (hb) { u32x2 w; w.x = cvt_pk_bf16(y[0], y[1]); w.y = cvt_pk_bf16(y[2], y[3]); *(u32x2*)(hb + c) = w; }
        if (fo) *(f32x4*)(fo + c) = y; }
}
#define LN_ROWS(r0, rend, step, ZROW, HBROW, FOROW) do { int r_ = (r0); if (r_ < (rend)) { f32x4 va_[8], vb_[8]; ln_load(va_, ZROW(r_), lane);      \
        for (;;) { const int r1_ = r_ + (step); if (r1_ < (rend)) ln_load(vb_, ZROW(r1_), lane); ln_apply(va_, lg_, lb_, HBROW(r_), FOROW(r_), lane); if (r1_ >= (rend)) break; \
                   const int r2_ = r1_ + (step); if (r2_ < (rend)) ln_load(va_, ZROW(r2_), lane); ln_apply(vb_, lg_, lb_, HBROW(r1_), FOROW(r1_), lane); if (r2_ >= (rend)) break; r_ = r2_; } } } while (0)

__device__ __forceinline__ void conv_silu8(const bf16_t* __restrict__ PROJ, const float* __restrict__ cw, const float* __restrict__ cb, int row, int ch, float (&y)[8]) {
    const f32x4 b0 = *(const f32x4*)(cb + ch), b1 = *(const f32x4*)(cb + ch + 4);
    float a[8] = {b0[0], b0[1], b0[2], b0[3], b1[0], b1[1], b1[2], b1[3]};
#pragma unroll
    for (int k = 0; k < 4; ++k) { const int rr = row - 3 + k;
        if (rr >= 0) { const u32x4 x = *(const u32x4*)(PROJ + (size_t)rr * PW + ch);
            const f32x4 w0 = *(const f32x4*)(cw + k * 1024 + ch), w1 = *(const f32x4*)(cw + k * 1024 + ch + 4);
            a[0] += w0[0] * bflo(x.x); a[1] += w0[1] * bfhi(x.x); a[2] += w0[2] * bflo(x.y); a[3] += w0[3] * bfhi(x.y);
            a[4] += w1[0] * bflo(x.z); a[5] += w1[1] * bfhi(x.z); a[6] += w1[2] * bflo(x.w); a[7] += w1[3] * bfhi(x.w); } }
#pragma unroll
    for (int i = 0; i < 8; ++i) y[i] = a[i] * sigmoidf(a[i]);
}

__device__ __forceinline__ int tsw(int row, int t) { return ((((t >> 1) + 4 * ((row >> 3) & 7)) & 31) << 1) | (t & 1); }

__device__ __forceinline__ void mlstm_local_unit(const Params& P, int l, int h, int n, char* lds) {
    int tid_ = threadIdx.x; asm volatile("" : "+v"(tid_));
    const int tid = tid_, wid = __builtin_amdgcn_readfirstlane(tid >> 6), lane = tid & 63, r32 = lane & 31, hi = lane >> 5;
    const bf16_t* PROJ = (const bf16_t*)(P.ws + WS_PROJ); const float* GATES = (const float*)(P.ws + WS_GATES);
    float* GM = (float*)(P.ws + WS_GM); float* NLOC = (float*)(P.ws + WS_NLOC); bf16_t* CT = (bf16_t*)(P.ws + WS_CT);
    const float* cw = P.in[3] + l * 4096; const float* cb = P.in[4] + l * 1024;
    bf16_t* KT = (bf16_t*)lds; bf16_t* VT = (bf16_t*)(lds + 18432); float* wl = (float*)(lds + 55296);
    const int t0 = n * 64;
    u32x4 kx[2][4], vx[4];
#pragma unroll
    for (int i = 0; i < 2; ++i) { const int idx = tid + 512 * i, t = idx >> 4, c = idx & 15;
#pragma unroll
        for (int k = 0; k < 4; ++k) { const int rr = t0 + t - 3 + k; kx[i][k] = (u32x4){0u, 0u, 0u, 0u};
            if (rr >= 0) kx[i][k] = *(const u32x4*)(PROJ + (size_t)rr * PW + C_MK + h * 128 + c * 8); } }
#pragma unroll
    for (int i = 0; i < 4; ++i) { const int idx = tid + 512 * i, t = idx >> 5, c = idx & 31; vx[i] = *(const u32x4*)(PROJ + (size_t)(t0 + t) * PW + C_MV + h * 256 + c * 8); }
    if (wid == 0) {
        const int row = t0 + lane;
        const float li = GATES[(size_t)row * 16 + h] + P.in[5][l * 4 + h];
        const float lf = logsigmoid(GATES[(size_t)row * 16 + 4 + h] + P.in[6][l * 4 + h]);
        const float b = wave_scan_add(lf, lane);
        const float g = __shfl(b, 63);
        const float a = g - b + li;
        const float ml = wave_max(a);
        wl[lane] = __expf(a - ml);
        if (lane == 0) { GM[(h * NCH + n) * 2] = g; GM[(h * NCH + n) * 2 + 1] = ml; }
    }
    __syncthreads();
#pragma unroll
    for (int i = 0; i < 2; ++i) { const int idx = tid + 512 * i, t = idx >> 4, c = idx & 15; const int ch = C_MK + h * 128 + c * 8;
        const f32x4 b0 = *(const f32x4*)(cb + ch), b1 = *(const f32x4*)(cb + ch + 4);
        float a[8] = {b0[0], b0[1], b0[2], b0[3], b1[0], b1[1], b1[2], b1[3]};
#pragma unroll
        for (int k = 0; k < 4; ++k) { const u32x4 x = kx[i][k];
            const f32x4 w0 = *(const f32x4*)(cw + k * 1024 + ch), w1 = *(const f32x4*)(cw + k * 1024 + ch + 4);
            a[0] += w0[0] * bflo(x.x); a[1] += w0[1] * bfhi(x.x); a[2] += w0[2] * bflo(x.y); a[3] += w0[3] * bfhi(x.y);
            a[4] += w1[0] * bflo(x.z); a[5] += w1[1] * bfhi(x.z); a[6] += w1[2] * bflo(x.w); a[7] += w1[3] * bfhi(x.w); }
        const float w = wl[t];
#pragma unroll
        for (int j = 0; j < 8; ++j) KT[(c * 8 + j) * 72 + tsw(c * 8, t)] = (bf16_t)(cvt_pk_bf16(a[j] * sigmoidf(a[j]) * w, 0.f) & 0xffffu); }
#pragma unroll
    for (int i = 0; i < 4; ++i) { const int idx = tid + 512 * i, t = idx >> 5, c = idx & 31;
        const u32x4 x = vx[i];
        bf16_t* vp = VT + (c * 8) * 72 + tsw(c * 8, t);
        vp[0] = (bf16_t)(x.x & 0xffffu); vp[72] = (bf16_t)(x.x >> 16); vp[144] = (bf16_t)(x.y & 0xffffu); vp[216] = (bf16_t)(x.y >> 16);
        vp[288] = (bf16_t)(x.z & 0xffffu); vp[360] = (bf16_t)(x.z >> 16); vp[432] = (bf16_t)(x.w & 0xffffu); vp[504] = (bf16_t)(x.w >> 16); }
    __syncthreads();
    const int db = wid & 3, eb0 = (wid >> 2) * 4;
    f32x16 acc[4] = {};
#pragma unroll
    for (int ks = 0; ks < 4; ++ks) { const bf16x8 A = *(const bf16x8*)(KT + (32 * db + r32) * 72 + tsw(32 * db + r32, 16 * ks + 8 * hi));
#pragma unroll
        for (int j = 0; j < 4; ++j) { const bf16x8 B = *(const bf16x8*)(VT + (32 * (eb0 + j) + r32) * 72 + tsw(32 * (eb0 + j) + r32, 16 * ks + 8 * hi));
            acc[j] = __builtin_amdgcn_mfma_f32_32x32x16_bf16(A, B, acc[j], 0, 0, 0); } }
    if (tid < 128) { float s = 0.f;
#pragma unroll
        for (int q = 0; q < 8; ++q) { const u32x4 x = *(const u32x4*)(KT + tid * 72 + 8 * q);
            s += (bflo(x.x) + bfhi(x.x)) + (bflo(x.y) + bfhi(x.y)) + (bflo(x.z) + bfhi(x.z)) + (bflo(x.w) + bfhi(x.w)); }
        NLOC[(size_t)(h * NCH + n) * 128 + tid] = s; }
    bf16_t* ct = CT + (size_t)(h * NCH + n) * 32768;
#pragma unroll
    for (int j = 0; j < 4; ++j) { const int e = 32 * (eb0 + j) + r32;
#pragma unroll
        for (int q = 0; q < 4; ++q) { u32x2 w; w.x = cvt_pk_bf16(acc[j][4 * q], acc[j][4 * q + 1]); w.y = cvt_pk_bf16(acc[j][4 * q + 2], acc[j][4 * q + 3]);
            *(u32x2*)(ct + e * 128 + 32 * db + 8 * q + 4 * hi) = w; } }
    __syncthreads();
}

__device__ __forceinline__ void fox_cumsum(const Params& P, int l, int head, char* lds) {
    int tidl_ = threadIdx.x; asm volatile("" : "+v"(tidl_));
    const int tid = tidl_, wid = tid >> 6, lane = tid & 63;
    const float* GATES = (const float*)(P.ws + WS_GATES); float* CF = (float*)(P.ws + WS_CF) + (size_t)head * CFP;
    const float fb = P.in[8][l * 8 + head];
    double* tot = (double*)(lds + 4096);
    const int base = 33 * tid;
    float lf[33];
#pragma unroll
    for (int k = 0; k < 33; ++k) { const int t = base + k; lf[k] = t < LTOK ? GATES[(size_t)t * 16 + 8 + head] : 0.f; }
    double s = 0.0;
#pragma unroll
    for (int k = 0; k < 33; ++k) { const int t = base + k; lf[k] = t < LTOK ? logsigmoid(lf[k] + fb) : 0.f; s += (double)lf[k]; }
    double inc = s;
#pragma unroll
    for (int o = 1; o < 64; o <<= 1) { const double y = __shfl_up(inc, o); if (lane >= o) inc += y; }
    if (lane == 63) tot[wid] = inc;
    __syncthreads();
    double run = inc - s;
    for (int w = 0; w < wid; ++w) run += tot[w];
#pragma unroll
    for (int k = 0; k < 33; ++k) { run += (double)lf[k]; CF[base + k] = (float)run; }
    __syncthreads();
}

__device__ __forceinline__ void fox_norms(const Params& P, int l, int gw, int NGW, int lane) {
    const bf16_t* PROJ = (const bf16_t*)(P.ws + WS_PROJ); unsigned* nrm = (unsigned*)(P.ws + WS_CTL) + 512 + l * 1024;
    float mq = 0.f, mk = 0.f;
    for (int base = gw * 8; base < LTOK; base += NGW * 8) {
        float dmin = 0.f;
        for (int i = 0; i < 8; ++i) { const int r = base + i; if (r >= LTOK) break;
            const u32x4* q = (const u32x4*)(PROJ + (size_t)r * PW + C_FQ + lane * 16); const u32x4* k = (const u32x4*)(PROJ + (size_t)r * PW + C_FK + lane * 16);
            float sq = 0.f, sk = 0.f, qk = 0.f;
#pragma unroll
            for (int j = 0; j < 2; ++j) { const u32x4 a = q[j], b = k[j];
                sq += bflo(a.x) * bflo(a.x) + bfhi(a.x) * bfhi(a.x) + bflo(a.y) * bflo(a.y) + bfhi(a.y) * bfhi(a.y) + bflo(a.z) * bflo(a.z) + bfhi(a.z) * bfhi(a.z) + bflo(a.w) * bflo(a.w) + bfhi(a.w) * bfhi(a.w);
                sk += bflo(b.x) * bflo(b.x) + bfhi(b.x) * bfhi(b.x) + bflo(b.y) * bflo(b.y) + bfhi(b.y) * bfhi(b.y) + bflo(b.z) * bflo(b.z) + bfhi(b.z) * bfhi(b.z) + bflo(b.w) * bflo(b.w) + bfhi(b.w) * bfhi(b.w);
                qk += bflo(a.x) * bflo(b.x) + bfhi(a.x) * bfhi(b.x) + bflo(a.y) * bflo(b.y) + bfhi(a.y) * bfhi(b.y) + bflo(a.z) * bflo(b.z) + bfhi(a.z) * bfhi(b.z) + bflo(a.w) * bflo(b.w) + bfhi(a.w) * bfhi(b.w); }
            sq += __shfl_xor(sq, 1); sq += __shfl_xor(sq, 2); sq += __shfl_xor(sq, 4); sk += __shfl_xor(sk, 1); sk += __shfl_xor(sk, 2); sk += __shfl_xor(sk, 4);
            qk += __shfl_xor(qk, 1); qk += __shfl_xor(qk, 2); qk += __shfl_xor(qk, 4);
            mq = fmaxf(mq, sq); mk = fmaxf(mk, sk); dmin = fminf(dmin, qk * fox::SCALE - 1e-3f * fabsf(qk * fox::SCALE)); }
        if ((lane & 7) == 0) { const int bits = (int)__float_as_uint(dmin); atomicMin((int*)nrm + 128 + (lane >> 3) * 80 + (base >> 8), bits ^ ((bits >> 31) & 0x7fffffff)); }
    }
    if ((lane & 7) == 0) { atomicMax(nrm + (lane >> 3) * 2, __float_as_uint(mq)); atomicMax(nrm + (lane >> 3) * 2 + 1, __float_as_uint(mk)); }
}

__device__ __forceinline__ void mlstm_scan_item(const Params& P, int item) {
    int tid_ = threadIdx.x; asm volatile("" : "+v"(tid_));
    const int tid = tid_, h = item >> 3, sl = item & 7;
    bf16_t* p = (bf16_t*)(P.ws + WS_CT) + (size_t)h * NCH * 32768 + sl * 4096 + tid * 8;
    int zv = 0; asm volatile("" : "+v"(zv));
    const float* GM = (const float*)(P.ws + WS_GM) + (size_t)h * NCH * 2 + zv;
    float* MPREV = (float*)(P.ws + WS_MPREV) + h * NCH;
    const bool hasn = (sl == 0) && tid < 128, wm = (sl == 0) && tid == 0;
    float* np = (float*)(P.ws + WS_NLOC) + (size_t)h * NCH * 128 + tid;
    float c0 = 0.f, c1 = 0.f, c2 = 0.f, c3 = 0.f, c4 = 0.f, c5 = 0.f, c6 = 0.f, c7 = 0.f, ncar = 0.f, m = 0.f;
#define PACK_CARRY() (u32x4){cvt_pk_bf16(c0, c1), cvt_pk_bf16(c2, c3), cvt_pk_bf16(c4, c5), cvt_pk_bf16(c6, c7)}
    for (int n0 = 0; n0 < 256; n0 += 16) {
        u32x4 cl[16]; float nl[16];
#pragma unroll
        for (int j = 0; j < 16; ++j) cl[j] = *(const u32x4*)(p + (size_t)(n0 + j) * 32768);
        if (hasn) {
#pragma unroll
            for (int j = 0; j < 16; ++j) nl[j] = np[(size_t)(n0 + j) * 128];
        } else {
#pragma unroll
            for (int j = 0; j < 16; ++j) nl[j] = 0.f;
        }
#pragma unroll
        for (int j = 0; j < 16; ++j) { const int n = n0 + j; const float g = GM[n * 2], ml = GM[n * 2 + 1];
            *(u32x4*)(p + (size_t)n * 32768) = PACK_CARRY();
            if (hasn) np[(size_t)n * 128] = ncar;
            if (wm) MPREV[n] = m;
            const float mn = fmaxf(g + m, ml), sp = __expf(g + m - mn), sq = __expf(ml - mn);
            c0 = sp * c0 + sq * bflo(cl[j].x); c1 = sp * c1 + sq * bfhi(cl[j].x); c2 = sp * c2 + sq * bflo(cl[j].y); c3 = sp * c3 + sq * bfhi(cl[j].y);
            c4 = sp * c4 + sq * bflo(cl[j].z); c5 = sp * c5 + sq * bfhi(cl[j].z); c6 = sp * c6 + sq * bflo(cl[j].w); c7 = sp * c7 + sq * bfhi(cl[j].w);
            ncar = sp * ncar + sq * nl[j]; m = mn; }
    }
    *(u32x4*)(p + (size_t)256 * 32768) = PACK_CARRY();
    if (hasn) np[(size_t)256 * 128] = ncar;
    if (wm) MPREV[256] = m;
#undef PACK_CARRY
}

__device__ __forceinline__ void mlstm_out_unit(const Params& P, int l, int h, int n, char* lds) {
    int tid_ = threadIdx.x; asm volatile("" : "+v"(tid_));
    const int tid = tid_, wid = __builtin_amdgcn_readfirstlane(tid >> 6), lane = tid & 63, r32 = lane & 31, hi = lane >> 5;
    const bf16_t* PROJ = (const bf16_t*)(P.ws + WS_PROJ); const float* GATES = (const float*)(P.ws + WS_GATES);
    const float* NPREV = (const float*)(P.ws + WS_NLOC) + (size_t)(h * NCH + n) * 128; const float* MPREV = (const float*)(P.ws + WS_MPREV);
    const bf16_t* ct = (const bf16_t*)(P.ws + WS_CT) + (size_t)(h * NCH + n) * 32768; bf16_t* MIX = (bf16_t*)(P.ws + WS_MIX);
    const float* cw = P.in[3] + l * 4096; const float* cb = P.in[4] + l * 1024; const float* mnorm = P.in[7] + l * 1024 + h * 256;
    bf16_t* Ql = (bf16_t*)lds; bf16_t* Kl = (bf16_t*)(lds + 17408); bf16_t* VT = (bf16_t*)(lds + 34816); bf16_t* Wl = (bf16_t*)(lds + 71680);
    float* tab = (float*)(lds + 80896); float* ul = tab, * vl = tab + 64, * sil = tab + 128, * eml = tab + 192, * rden = tab + 256, * npv = tab + 320;
    float* Hb = (float*)lds;
    const int t0 = n * 64;
    if (wid == 0) {
        const int row = t0 + lane;
        const float li = GATES[(size_t)row * 16 + h] + P.in[5][l * 4 + h];
        const float lf = logsigmoid(GATES[(size_t)row * 16 + 4 + h] + P.in[6][l * 4 + h]);
        const float b = wave_scan_add(lf, lane);
        const float v = li - b;
        const float pm = wave_scan_max(v, lane);
        int zv = 0; asm volatile("" : "+v"(zv));
        const float mp = MPREV[h * NCH + n + zv];
        const float mx = fmaxf(mp, pm);
        ul[lane] = -mx; vl[lane] = v; sil[lane] = __expf(mp - mx); eml[lane] = __expf(-(b + mx));
    } else if (wid <= 2) { const int d = tid - 64; npv[d] = NPREV[d]; }
#pragma unroll
    for (int i = 0; i < 4; ++i) { const int idx = tid + 512 * i, which = idx >> 10, t = (idx >> 4) & 63, c = idx & 15; float y[8];
        conv_silu8(PROJ, cw, cb, t0 + t, which * 512 + h * 128 + c * 8, y);
        const float sc = which ? 1.f : 0.08838834764831845f;
        u32x4 w; w.x = cvt_pk_bf16(y[0] * sc, y[1] * sc); w.y = cvt_pk_bf16(y[2] * sc, y[3] * sc); w.z = cvt_pk_bf16(y[4] * sc, y[5] * sc); w.w = cvt_pk_bf16(y[6] * sc, y[7] * sc);
        *(u32x4*)((which ? Kl : Ql) + t * 136 + c * 8) = w; }
#pragma unroll
    for (int i = 0; i < 4; ++i) { const int idx = tid + 512 * i, t = idx >> 5, c = idx & 31;
        const u32x4 x = *(const u32x4*)(PROJ + (size_t)(t0 + t) * PW + C_MV + h * 256 + c * 8);
        bf16_t* vp = VT + (c * 8) * 72 + tsw(c * 8, t);
        vp[0] = (bf16_t)(x.x & 0xffffu); vp[72] = (bf16_t)(x.x >> 16); vp[144] = (bf16_t)(x.y & 0xffffu); vp[216] = (bf16_t)(x.y >> 16);
        vp[288] = (bf16_t)(x.z & 0xffffu); vp[360] = (bf16_t)(x.z >> 16); vp[432] = (bf16_t)(x.w & 0xffffu); vp[504] = (bf16_t)(x.w >> 16); }
    bf16x8 cfr[8];
#pragma unroll
    for (int ks = 0; ks < 8; ++ks) cfr[ks] = *(const bf16x8*)(ct + (size_t)(32 * wid + r32) * 128 + 16 * ks + 8 * hi);
    __syncthreads();
    if (wid < 4) {
        const int ti = wid >> 1, si = wid & 1;
        f32x16 acc = {};
        if (si <= ti) {
#pragma unroll
            for (int ks = 0; ks < 8; ++ks) { const bf16x8 A = *(const bf16x8*)(Ql + (32 * ti + r32) * 136 + 16 * ks + 8 * hi);
                const bf16x8 B = *(const bf16x8*)(Kl + (32 * si + r32) * 136 + 16 * ks + 8 * hi);
                acc = __builtin_amdgcn_mfma_f32_32x32x16_bf16(A, B, acc, 0, 0, 0); }
        }
        const int s = 32 * si + r32; const float vs = vl[s];
#pragma unroll
        for (int r = 0; r < 16; ++r) { const int t = 32 * ti + fox::crow(r, hi);
            const float wv = (s <= t) ? acc[r] * __expf(ul[t] + vs) : 0.f;
            Wl[t * 72 + s] = (bf16_t)(cvt_pk_bf16(wv, 0.f) & 0xffffu); }
    }
    __syncthreads();
    {
        const int t = tid >> 3, p = tid & 7;
        const u32x4 x = *(const u32x4*)(Wl + t * 72 + 8 * p);
        float ws_ = (bflo(x.x) + bfhi(x.x)) + (bflo(x.y) + bfhi(x.y)) + (bflo(x.z) + bfhi(x.z)) + (bflo(x.w) + bfhi(x.w));
        const u32x4 q0 = *(const u32x4*)(Ql + t * 136 + 16 * p), q1 = *(const u32x4*)(Ql + t * 136 + 16 * p + 8);
        const float* nn = npv + 16 * p;
        float qn = bflo(q0.x) * nn[0] + bfhi(q0.x) * nn[1] + bflo(q0.y) * nn[2] + bfhi(q0.y) * nn[3] + bflo(q0.z) * nn[4] + bfhi(q0.z) * nn[5] + bflo(q0.w) * nn[6] + bfhi(q0.w) * nn[7]
                 + bflo(q1.x) * nn[8] + bfhi(q1.x) * nn[9] + bflo(q1.y) * nn[10] + bfhi(q1.y) * nn[11] + bflo(q1.z) * nn[12] + bfhi(q1.z) * nn[13] + bflo(q1.w) * nn[14] + bfhi(q1.w) * nn[15];
        float tot = ws_ + sil[t] * qn;
        tot += __shfl_xor(tot, 1); tot += __shfl_xor(tot, 2); tot += __shfl_xor(tot, 4);
        if (p == 0) rden[t] = 1.f / fmaxf(fabsf(tot), eml[t]);
    }
    f32x16 a1[2] = {}, a2[2] = {};
#pragma unroll
    for (int ks = 0; ks < 4; ++ks) { const bf16x8 B = *(const bf16x8*)(VT + (32 * wid + r32) * 72 + tsw(32 * wid + r32, 16 * ks + 8 * hi));
#pragma unroll
        for (int ti = 0; ti < 2; ++ti) { const bf16x8 A = *(const bf16x8*)(Wl + (32 * ti + r32) * 72 + 16 * ks + 8 * hi);
            a1[ti] = __builtin_amdgcn_mfma_f32_32x32x16_bf16(A, B, a1[ti], 0, 0, 0); } }
#pragma unroll
    for (int ks = 0; ks < 8; ++ks) {
#pragma unroll
        for (int ti = 0; ti < 2; ++ti) { const bf16x8 A = *(const bf16x8*)(Ql + (32 * ti + r32) * 136 + 16 * ks + 8 * hi);
            a2[ti] = __builtin_amdgcn_mfma_f32_32x32x16_bf16(A, cfr[ks], a2[ti], 0, 0, 0); } }
    __syncthreads();
#pragma unroll
    for (int ti = 0; ti < 2; ++ti)
#pragma unroll
        for (int r = 0; r < 16; ++r) { const int t = 32 * ti + fox::crow(r, hi);
            Hb[t * 260 + 32 * wid + r32] = (a1[ti][r] + sil[t] * a2[ti][r]) * rden[t]; }
    __syncthreads();
    {
        const int t = tid >> 3, p = tid & 7; f32x4 hv[8]; float ss = 0.f;
#pragma unroll
        for (int j = 0; j < 8; ++j) { hv[j] = *(const f32x4*)(Hb + t * 260 + 32 * j + 4 * p); ss += (hv[j][0] * hv[j][0] + hv[j][1] * hv[j][1]) + (hv[j][2] * hv[j][2] + hv[j][3] * hv[j][3]); }
        ss += __shfl_xor(ss, 1); ss += __shfl_xor(ss, 2); ss += __shfl_xor(ss, 4);
        const float rs = rsqrtf(ss * (1.f / 256.f) + RMS_EPS);
        const size_t row = (size_t)(t0 + t);
#pragma unroll
        for (int j = 0; j < 8; ++j) { const int e = 32 * j + 4 * p; const f32x4 gn = *(const f32x4*)(mnorm + e);
            const u32x2 mo = *(const u32x2*)(PROJ + row * PW + C_MO + h * 256 + e);
            const float o0 = hv[j][0] * rs * gn[0] * sigmoidf(bflo(mo.x)), o1 = hv[j][1] * rs * gn[1] * sigmoidf(bfhi(mo.x));
            const float o2 = hv[j][2] * rs * gn[2] * sigmoidf(bflo(mo.y)), o3 = hv[j][3] * rs * gn[3] * sigmoidf(bfhi(mo.y));
            u32x2 w; w.x = cvt_pk_bf16(o0, o1); w.y = cvt_pk_bf16(o2, o3);
            *(u32x2*)(MIX + row * DM + h * 256 + e) = w; }
    }
    __syncthreads();
}

#define XB_TMO      128
#define XB_XCNT(j)  (256  + 64 * (j))
#define XB_XSUB(j)  (1280 + 64 * (j))
#define XB_XGEN(j)  (2304 + 64 * (j))
#define XB_TOP      3328
#define XB_TOPGEN   3392
#define XCD_BAR_WORDS 3456
#define XB_SPIN_CAP (1u << 18)

__device__ __forceinline__ unsigned xb_ld(unsigned* p)              { return __hip_atomic_load(p, __ATOMIC_RELAXED, __HIP_MEMORY_SCOPE_AGENT); }
__device__ __forceinline__ unsigned xb_add(unsigned* p, unsigned v) { return __hip_atomic_fetch_add(p, v, __ATOMIC_RELAXED, __HIP_MEMORY_SCOPE_AGENT); }
__device__ __forceinline__ unsigned xb_xcc_id() { return (unsigned)__builtin_amdgcn_s_getreg((3 << 11) | 20) & 0xFu; }
#define XB_SPIN(cond, bar) do { unsigned _sp = 0; while (cond) { __builtin_amdgcn_s_sleep(1); \
    if ((++_sp & 255u) == 0u) { if (xb_ld(&(bar)[XB_TMO])) break; if (_sp > XB_SPIN_CAP) { atomicAdd(&(bar)[XB_TMO], 1u); break; } } } } while (0)

struct XcdBarrier {
    unsigned* bar; unsigned x;
    volatile LAS unsigned* st;
};

__device__ __forceinline__ XcdBarrier xcd_barrier_post(unsigned* bar, volatile LAS unsigned* st) {
    XcdBarrier b; b.bar = bar; b.x = xb_xcc_id(); b.st = st;
    if (threadIdx.x == 0) (void)xb_add(&bar[XB_XCNT(b.x)], 1u);
    return b;
}
__device__ __forceinline__ void xcd_barrier_complete(unsigned* bar, unsigned x, unsigned& nloc, unsigned& nx) {
    const unsigned G = gridDim.x * gridDim.y * gridDim.z;
    unsigned sum, cnt, mine, sp = 0u;
    for (;;) {
        sum = 0u; cnt = 0u; mine = 0u;
#pragma unroll
        for (unsigned j = 0; j < 16; ++j) { const unsigned c = xb_ld(&bar[XB_XCNT(j)]); sum += c; cnt += (c > 0u) ? 1u : 0u; mine = (j == x) ? c : mine; }
        if (sum == G) break;
        __builtin_amdgcn_s_sleep(1);
        if ((++sp & 255u) == 0u) { if (xb_ld(&bar[XB_TMO])) break; if (sp > XB_SPIN_CAP) { atomicAdd(&bar[XB_TMO], 1u); break; } }
    }
    nloc = mine > 0u ? mine : 1u; nx = cnt > 0u ? cnt : 1u;
}

__device__ __forceinline__ void xcd_barrier(const XcdBarrier& b) {
    asm volatile("s_waitcnt vmcnt(0)" ::: "memory");
    __syncthreads();
    if (threadIdx.x == 0) {
        unsigned* bar = b.bar;
        __builtin_amdgcn_s_waitcnt(0);
        unsigned nloc = b.st[0], nx = b.st[1];
        if (nloc == 0u) { xcd_barrier_complete(bar, b.x, nloc, nx); b.st[0] = nloc; b.st[1] = nx; }
        const unsigned old = xb_add(&bar[XB_XSUB(b.x)], 1u);
        const unsigned gen = old / nloc;
        if (old + 1u == (gen + 1u) * nloc) {
            __builtin_amdgcn_fence(__ATOMIC_RELEASE, "agent");
            asm volatile("s_waitcnt vmcnt(0)" ::: "memory");
            const unsigned og = xb_add(&bar[XB_TOP], 1u);
            const unsigned tg = og / nx;
            if (og + 1u == (tg + 1u) * nx) xb_add(&bar[XB_TOPGEN], 1u);
            else XB_SPIN(xb_ld(&bar[XB_TOPGEN]) == tg, bar);
            __builtin_amdgcn_fence(__ATOMIC_ACQUIRE, "agent");
            xb_add(&bar[XB_XGEN(b.x)], 1u);
            asm volatile("s_waitcnt vmcnt(0)" ::: "memory");
        } else {
            XB_SPIN(xb_ld(&bar[XB_XGEN(b.x)]) == gen, bar);
            __builtin_amdgcn_fence(__ATOMIC_ACQUIRE, "agent");
            asm volatile("s_waitcnt vmcnt(0)" ::: "memory");
        }
    }
    __syncthreads();
}

constexpr int CW_BAR = 4096;
#ifndef TEST_SP
#define TEST_EN(k) true
#else
#define TEST_EN(k) ((k) == TEST_SP)
#endif
#ifndef PROBE_DUP
#define PROBE_DUP -1
#endif
constexpr int NPHASE = 19;
#define PH_IN(k) (P0.ph_lo <= (k) && (k) < P0.ph_hi)
#define PH_SYNC(k) do { if (PH_IN(k) && PH_IN((k) + 1)) { if (P0.ph_lo < 0) { __threadfence(); cg::this_grid().sync(); }   { \
        XcdBarrier bar_; bar_.bar = (unsigned*)(load_params().ws + WS_CTL) + CW_BAR; bar_.x = xb_xcc_id(); bar_.st = (volatile LAS unsigned*)((LAS char*)lds + LDS_MISC + 64); xcd_barrier(bar_); if (PROBE_DUP == 10) xcd_barrier(bar_); } } } while (0)

#define PH_SYNC_ALWAYS() do { XcdBarrier bar_; bar_.bar = (unsigned*)(load_params().ws + WS_CTL) + CW_BAR; bar_.x = xb_xcc_id(); bar_.st = (volatile LAS unsigned*)((LAS char*)lds + LDS_MISC + 64); xcd_barrier(bar_); } while (0)
__device__ __forceinline__ Params load_params() {
    typedef const unsigned long long __attribute__((address_space(4)))* kptr_t;
    kptr_t p = (kptr_t)__builtin_amdgcn_kernarg_segment_ptr();
    asm volatile("" : "+s"(p));
    Params r;
#pragma unroll
    for (int i = 0; i < 17; ++i) r.in[i] = (const float*)p[i];
    r.out = (float*)p[17]; r.ws = (unsigned char*)p[18]; r.ph_lo = 0; r.ph_hi = 0;
    return r;
}
#define PH_BEGIN const Params P = load_params(); unsigned char* ws = P.ws;
template <int L, int K>
__device__ __forceinline__ void phase_body(char* lds, int rep_) {
    int tidl_ = threadIdx.x; asm volatile("" : "+v"(tidl_));
    const int tid = tidl_, lane = tid & 63, wid = __builtin_amdgcn_readfirstlane(tid >> 6);
    const int G = gridDim.x, bx = blockIdx.x;
    const int gw = bx * 8 + wid, NGW = G * 8;
    PG8_LAS unsigned char* glds = (PG8_LAS unsigned char*)lds;
    (void)lane; (void)gw; (void)NGW; (void)glds; (void)rep_;
    if constexpr (K == 0) { PH_BEGIN
        const bf16_t* HB = (const bf16_t*)(ws + WS_HB); const bf16_t* WinT = (const bf16_t*)(ws + WS_WIN);
        skinny_gemm<2>(WinT + (size_t)PW * DM, DM, HB, DM, DM, SEQ / 16, lds, SkGates{(float*)(ws + WS_GATES)});
        skinny_gemm<8>(WinT + (size_t)PW * DM, DM, HB + (size_t)SEQ * DM, DM, DM, 1, lds, SkGates{(float*)(ws + WS_GATES) + (size_t)SEQ * 16});
        skinny_gemm<4>(HB, DM, WinT, DM, DM, PW / 16, lds, SkProj{(bf16_t*)(ws + WS_PROJ)});
        pg8::Gemm g{HB + (size_t)NMETA * DM, WinT, SEQ, PW, DM, DM}; pg8::StaticOrder S; S.init(SEQ, PW, G, bx);
        EpiProj E{(bf16_t*)(ws + WS_PROJ)};
        pg8::gemm_phase<EpiProj, pg8::StaticOrder, true, true>(glds, g, S, E);
    }
    if constexpr (K == 1) {
#define DEP_() ((unsigned*)(load_params().ws + WS_CTL) + 128 + L * 64 + rp_ * 32)
#ifdef PROBE_MIX
        int nrp_ = 2; asm volatile("" : "+s"(nrp_));
#else
        const int nrp_ = 1;
#endif
        for (int rp_ = 0; rp_ < nrp_; ++rp_) {
        const int xcc = (int)(xb_xcc_id() & 7u); const bool heavy = xcc >= 7;
        { const Params P = load_params(); fox_norms(P, L, gw, NGW, lane); if (bx < 8) fox_cumsum(P, L, bx, lds); }
        signal_done(DEP_() + 5);
        if (((bx >> 3) & 7) == 0) {
            const Params P = load_params();
            convert_weights(P, L, 2, lds, ((bx >> 6) * 8 + (bx & 7)) * 8 + wid, 32 * 8, wid, lane);
            __syncthreads();
        }
        int nstage_ = 2; asm volatile("" : "+s"(nstage_));
        for (int stage = 0; stage < nstage_; ++stage) {
            if ((stage == 0) == heavy) {
                wait_count(DEP_() + 5, (unsigned)G);
                const Params P = load_params(); unsigned char* ws = P.ws;
                unsigned* qh = (unsigned*)(ws + WS_CTL) + 16 + L * 16 + rp_ * 8; const unsigned* nrm = (unsigned*)(ws + WS_CTL) + 512 + L * 1024;
                bf16_t* PROJ = (bf16_t*)(ws + WS_PROJ); bf16_t* MIX = (bf16_t*)(ws + WS_MIX);
                const float* CF = (const float*)(ws + WS_CF); const float* fnorm = P.in[9] + L * 1024;
                for (;;) {
                    volatile int* slot = (volatile int*)(lds + LDS_MISC);
                    if (tid == 0) *slot = fox::fox_take(qh, xcc);
                    __syncthreads();
                    const int ci = __builtin_amdgcn_readfirstlane(*slot);
                    __syncthreads();
                    if (ci < 0) break;
                    fox::Seam S;
                    fox::BlockRef cur, nxt; fox::fox_ref(ci, cur, PROJ, MIX); cur.jlo = fox::fox_jlo(CF, nrm, cur.head, cur.P0);
                    fox::fox_prime(cur, lds, S);
                    for (;;) {
                        const bool more = fox::fox_block(cur, nxt, qh, nrm, PROJ, MIX, lds, S, CF, fnorm);
                        if (!more) break;
                        cur = nxt;
                    }
                }
            }
            if (stage == 0) {
                unsigned nloc_ = 0;
                for (;;) { const int u = fetch_item(DEP_() + 0, lds); if (u >= 1024) break; { const Params P = load_params(); mlstm_local_unit(P, L, u & 3, u >> 2, lds); } ++nloc_; }
                if (nloc_) signal_done(DEP_() + 1, nloc_);
                for (;;) { const int s = fetch_item(DEP_() + 2, lds); if (s >= 32) break; wait_count(DEP_() + 1, 1024u); { const Params P = load_params(); mlstm_scan_item(P, s); } signal_done(DEP_() + 3); }
            }
        }
        wait_count(DEP_() + 3, 32u);
        for (;;) { const int u = fetch_item(DEP_() + 4, lds); if (u >= 4 * NCH) break; const Params P = load_params(); mlstm_out_unit(P, L, u & 3, u >> 2, lds); }
        }
#undef DEP_
    }
    if constexpr (K == 4) { PH_BEGIN
        const bf16_t* MIX = (const bf16_t*)(ws + WS_MIX); const bf16_t* WoutT = (const bf16_t*)(ws + WS_WOUT); const bf16_t* HB = (const bf16_t*)(ws + WS_HB);
        skinny_gemm<8>(MIX, DM, WoutT, DM, DM, DM / 16, lds, SkRes{HB, (float*)(ws + WS_Z1)});
        pg8::Gemm g{MIX + (size_t)NMETA * DM, WoutT, SEQ, DM, DM, DM}; pg8::StaticOrder S; S.init(SEQ, DM, G, bx);
        EpiRes<0> E{HB, (float*)(ws + WS_Z1)};
        pg8::gemm_phase<EpiRes<0>, pg8::StaticOrder, true, true>(glds, g, S, E);
    }
    if constexpr (K == 5) { PH_BEGIN
        const float* g1 = P.in[11] + L * DM; const float* b1 = P.in[12] + L * DM; const float* Z1 = (const float*)(ws + WS_Z1); bf16_t* HB = (bf16_t*)(ws + WS_HB);
        const float* lg_ = g1; const float* lb_ = b1;
#define ZR_(r) (Z1 + (size_t)(r) * DM)
#define HR_(r) (HB + (size_t)(r) * DM)
#define FR_(r) ((float*)nullptr)
        LN_ROWS(gw, LTOK, NGW, ZR_, HR_, FR_);
#undef ZR_
#undef HR_
#undef FR_
    }
    if constexpr (K == 6) { PH_BEGIN
        const bf16_t* HB = (const bf16_t*)(ws + WS_HB); const bf16_t* WupT = (const bf16_t*)(ws + WS_WUP);
        skinny_gemm<4>(HB, DM, WupT, LDU, DM, DFF / 16, lds, SkSqRelu{(bf16_t*)(ws + WS_U)});
        pg8::Gemm g{HB + (size_t)NMETA * DM, WupT, SEQ, DFF, DM, LDU}; pg8::StaticOrder S; S.init(SEQ, DFF, G, bx);
        EpiSqRelu E{(bf16_t*)(ws + WS_U)};
        pg8::gemm_phase<EpiSqRelu, pg8::StaticOrder, true, true>(glds, g, S, E);
    }
    if constexpr (K == 7) { PH_BEGIN
        const bf16_t* U = (const bf16_t*)(ws + WS_U); const bf16_t* WdownT = (const bf16_t*)(ws + WS_WDOWN); const bf16_t* HB = (const bf16_t*)(ws + WS_HB);
        skinny_gemm<8>(U, DFF, WdownT, LDD, DFF, DM / 16, lds, SkRes{HB, (float*)(ws + WS_ZS)});
        pg8::Gemm g{U + (size_t)NMETA * DFF, WdownT, SEQ, DM, DFF, LDD}; pg8::StaticOrder S; S.init(SEQ, DM, G, bx);
        EpiRes<1> E{HB, P.out};
        pg8::gemm_phase<EpiRes<1>, pg8::StaticOrder, true, true>(glds, g, S, E);
    }
    if constexpr (K == 8) { PH_BEGIN
        const float* g2 = P.in[15] + L * DM; const float* b2 = P.in[16] + L * DM; const float* ZS = (const float*)(ws + WS_ZS); bf16_t* HB = (bf16_t*)(ws + WS_HB);
        if (L == 0) {
            const float* lg_ = g2; const float* lb_ = b2;
#define ZR_(r) ((r) >= NMETA ? P.out + (size_t)((r) - NMETA) * DM : ZS + (size_t)(r) * DM)
#define HR_(r) (HB + (size_t)(r) * DM)
#define FR_(r) ((float*)nullptr)
            LN_ROWS(gw, LTOK, NGW, ZR_, HR_, FR_);
#undef ZR_
#undef HR_
#undef FR_
            convert_weights(P, 1, 1, lds, gw, NGW, wid, lane);
            zero_pad_rows(P);
        } else {
            const float* lg_ = g2; const float* lb_ = b2;
#define ZR_(r) (P.out + (size_t)((r) - NMETA) * DM)
#define HR_(r) ((bf16_t*)nullptr)
#define FR_(r) (P.out + (size_t)((r) - NMETA) * DM)
            LN_ROWS(gw + NMETA, LTOK, NGW, ZR_, HR_, FR_);
#undef ZR_
#undef HR_
#undef FR_
        }
    }
}
template <int L>
__device__ __forceinline__ void run_layer(const Params& P0, char* lds) {
    constexpr int B0 = 1 + 9 * L;
    if (PH_IN(B0 + 0)) { if (TEST_EN(0)) { phase_body<L, 0>(lds, 0); if (PROBE_DUP == 0) phase_body<L, 0>(lds, 1); } }
    PH_SYNC(B0 + 0);
    if (PH_IN(B0 + 1)) { if (TEST_EN(1)) { phase_body<L, 1>(lds, 0); if (PROBE_DUP == 1) phase_body<L, 1>(lds, 1); } }
    if (PH_IN(B0 + 3)) PH_SYNC_ALWAYS();
    if (PH_IN(B0 + 4)) { if (TEST_EN(4)) { phase_body<L, 4>(lds, 0); if (PROBE_DUP == 4) phase_body<L, 4>(lds, 1); } }
    PH_SYNC(B0 + 4);
    if (PH_IN(B0 + 5)) { if (TEST_EN(5)) { phase_body<L, 5>(lds, 0); if (PROBE_DUP == 5) phase_body<L, 5>(lds, 1); } }
    PH_SYNC(B0 + 5);
    if (PH_IN(B0 + 6)) { if (TEST_EN(6)) { phase_body<L, 6>(lds, 0); if (PROBE_DUP == 6) phase_body<L, 6>(lds, 1); } }
    PH_SYNC(B0 + 6);
    if (PH_IN(B0 + 7)) { if (TEST_EN(7)) { phase_body<L, 7>(lds, 0); if (PROBE_DUP == 7) phase_body<L, 7>(lds, 1); } }
    PH_SYNC(B0 + 7);
    if (PH_IN(B0 + 8)) { if (TEST_EN(8)) { phase_body<L, 8>(lds, 0); if (PROBE_DUP == 8 && L == 0) phase_body<L, 8>(lds, 1); } }
    if (L == 0) PH_SYNC(B0 + 8);
}

__global__ void __launch_bounds__(512) hymba_fwd(Params P0) {
    extern __shared__ __attribute__((aligned(16))) char lds[];
    { volatile LAS unsigned* st = (volatile LAS unsigned*)((LAS char*)lds + LDS_MISC + 64);
      if (threadIdx.x < 2) st[threadIdx.x] = 0u;
      __syncthreads();
      (void)xcd_barrier_post((unsigned*)(load_params().ws + WS_CTL) + CW_BAR, st); }
    if (PH_IN(0)) { if (TEST_EN(9)) { int npro_ = (PROBE_DUP == 9) ? 2 : 1; asm volatile("" : "+s"(npro_)); for (int rp_ = 0; rp_ < npro_; ++rp_) { const Params P = load_params();
        int tidl_ = threadIdx.x; asm volatile("" : "+v"(tidl_));
    const int tid = tidl_, lane = tid & 63, wid = __builtin_amdgcn_readfirstlane(tid >> 6);
        const int gw = blockIdx.x * 8 + wid, NGW = gridDim.x * 8;
        const float* x = P.in[0]; const float* meta = P.in[1]; bf16_t* HB = (bf16_t*)(P.ws + WS_HB); unsigned* ctl = (unsigned*)(P.ws + WS_CTL);
        for (int r = gw; r < MP; r += NGW) {
            const float* src = r < NMETA ? meta + (size_t)r * DM : (r < LTOK ? x + (size_t)(r - NMETA) * DM : nullptr);
#pragma unroll
            for (int j = 0; j < 8; ++j) { const int c = (lane + 64 * j) * 4; f32x4 v = {0.f, 0.f, 0.f, 0.f}; if (src) v = *(const f32x4*)(src + c);
                u32x2 w; w.x = cvt_pk_bf16(v[0], v[1]); w.y = cvt_pk_bf16(v[2], v[3]); *(u32x2*)(HB + (size_t)r * DM + c) = w; }
        }
        convert_weights(P, 0, 1, lds, gw, NGW, wid, lane);
        zero_pad_rows(P);
        if (blockIdx.x == 0 && tid < 64) ctl[tid] = 0u;
    } } }
    PH_SYNC(0);
    run_layer<0>(P0, lds);
    run_layer<1>(P0, lds);
}

extern "C" void kernel_launch(void* const* d_in, const int* in_sizes, int n_in, void* d_out, int out_size, void* d_ws, size_t ws_size, hipStream_t stream) {
    static int grid = 0;
    if (grid == 0) {
        if (n_in != 17 || in_sizes[0] != SEQ * DM || out_size != SEQ * DM || ws_size < WS_END) { fprintf(stderr, "kernel_launch: unexpected shapes (n_in %d, in0 %d, out %d, ws %zu)\n", n_in, n_in > 0 ? in_sizes[0] : -1, out_size, ws_size); grid = -1; return; }
        int dev = 0, cus = 0, per_cu = 0;
        (void)hipGetDevice(&dev); (void)hipDeviceGetAttribute(&cus, hipDeviceAttributeMultiprocessorCount, dev);
        if (hipFuncSetAttribute((const void*)hymba_fwd, hipFuncAttributeMaxDynamicSharedMemorySize, LDS_BYTES) != hipSuccess) { fprintf(stderr, "kernel_launch: hipFuncSetAttribute failed\n"); grid = -1; return; }
        if (hipOccupancyMaxActiveBlocksPerMultiprocessor(&per_cu, (const void*)hymba_fwd, 512, LDS_BYTES) != hipSuccess || per_cu < 1) { fprintf(stderr, "kernel_launch: occupancy query says %d\n", per_cu); per_cu = 1; }
        (void)hipGetLastError();
        grid = cus > 0 ? cus : 256;
    }
    if (grid < 0) return;
    if (hipMemsetAsync((char*)d_ws + WS_CTL, 0, 32768, stream) != hipSuccess) { fprintf(stderr, "kernel_launch: memset failed\n"); return; }
    Params p{};
    for (int i = 0; i < 17; ++i) p.in[i] = (const float*)d_in[i];
    p.out = (float*)d_out; p.ws = (unsigned char*)d_ws;
#if MK_SINGLE
    p.ph_lo = 0; p.ph_hi = NPHASE;
    void* args[] = {&p};
    hipError_t e = hipLaunchCooperativeKernel((const void*)hymba_fwd, dim3(grid), dim3(512), args, LDS_BYTES, stream);
    if (e != hipSuccess) fprintf(stderr, "cooperative launch failed: %s (grid %d)\n", hipGetErrorString(e), grid);
#else
    for (int ph = 0; ph < NPHASE; ++ph) { p.ph_lo = ph; p.ph_hi = ph + 1; hipLaunchKernelGGL(hymba_fwd, dim3(grid), dim3(512), LDS_BYTES, stream, p); }
#endif
}
```

```cpp
#include <hip/hip_runtime.h>
#include <hip/hip_cooperative_groups.h>
#include <cstdio>
#include <cstdint>
namespace cg = cooperative_groups;

#ifndef MK_SINGLE
#define MK_SINGLE 1
#endif

namespace pg8 {
#define PG8_LAS __attribute__((address_space(3)))
typedef unsigned short bf16_t;
typedef short bf16x8 __attribute__((ext_vector_type(8)));
typedef float f32x4 __attribute__((ext_vector_type(4)));
typedef unsigned u32x4 __attribute__((ext_vector_type(4)));
constexpr int BM = 256, BK = 64, HALF = 128, HTB = HALF * BK * 2  , STAGE_BYTES = 8 * HTB, NXCD = 8, WGM = 4;

__host__ __device__ __forceinline__ int lds_byte(int r, int c) { const int st = (r >> 4) * 2 + (c >> 5), rr = r & 15, cc = c & 31, ob = rr * 64 + cc * 2; return st * 1024 + (ob ^ (((ob >> 9) & 1) << 5)); }
__host__ __device__ __forceinline__ void stage_rc(int b, int& R, int& C) { const int st = b / 1024, sb = b % 1024, swz = sb ^ (((sb >> 9) & 1) << 5); R = (st >> 1) * 16 + swz / 64; C = (st & 1) * 32 + (swz % 64) / 2; }
__host__ __device__ __forceinline__ int perm32(int rho) { const int n = rho >> 4, i = rho & 15; return 8 * (i >> 2) + 4 * n + (i & 3); }

struct Unit { int pm, pn; };
struct Gemm { const bf16_t* A; const bf16_t* Bt; int M, N, K; };

struct StaticOrder {
    int nM, nN, nwg, G, c;
    __host__ __device__ void init(int M, int N, int G_, int c_) { nM = M / BM; nN = N / BM; nwg = nM * nN; G = G_; c = c_; }
    __host__ __device__ bool next(int i, Unit& u) const {
        const long L = (long)i * G + c; if (L >= nwg) return false;
        int wgid = (int)L; { const int q = nwg / NXCD, r = nwg % NXCD, xcd = wgid % NXCD, off = wgid / NXCD; wgid = (xcd < r ? xcd * (q + 1) : r * (q + 1) + (xcd - r) * q) + off; }
        const int nig = WGM * nN, gid = wgid / nig, fm = gid * WGM, gsz = (nM - fm) < WGM ? (nM - fm) : WGM;
        u.pm = fm + ((wgid % nig) % gsz); u.pn = (wgid % nig) / gsz; return true;
    }
    __device__ __forceinline__ void a_ready(const Unit&) const {}
    __device__ __forceinline__ void done(const Unit&) const {}
};

template <class Epi, class Sched, bool ALIGN_EPI = false, bool SP2 = false>
__device__ __forceinline__ void gemm_phase(PG8_LAS unsigned char* lds, const Gemm g, const Sched& S, const Epi& E) {
    int tidl_ = threadIdx.x; asm volatile("" : "+v"(tidl_));
    const int tid = tidl_, wid = __builtin_amdgcn_readfirstlane(tid >> 6), lane = tid & 63, wr = wid >> 2, wc = wid & 3, fr = lane & 15, fq = lane >> 4;
    const int K = g.K, nt = K / BK;
    unsigned voffA[2], voffB[2];
#pragma unroll
    for (int i = 0; i < 2; ++i) { int R, C; stage_rc(tid * 16 + i * 8192, R, C); const int Rb = Epi::PERM ? ((R & ~31) + perm32(R & 31)) : R;
        voffA[i] = (unsigned)(R * K + C) * 2u; voffB[i] = (unsigned)(Rb * K + C) * 2u; }
    const size_t kstep = (size_t)(BK * 2);
    const size_t hstep = (size_t)HALF * K * 2;
    const size_t tstep = 2 * hstep;
    const unsigned ldsw = (unsigned)wid * 1024u;
    const int aoff = lds_byte(wr * 64 + fr, fq * 8), boff = lds_byte(wc * 32 + fr, fq * 8);
#define PG8_SA(b, h) (((b) * 2 + (h)) * HTB)
#define PG8_SB(b, h) ((4 + (b) * 2 + (h)) * HTB)
#define PG8_STAGE(bufoff, gbase, voff) do { _Pragma("unroll") for (int _i = 0; _i < 2; ++_i) \
        __builtin_amdgcn_global_load_lds((const unsigned*)((const char*)(gbase) + (voff)[_i]), (PG8_LAS unsigned*)(lds + (bufoff) + ldsw + _i * 8192), 16, 0, 0); } while (0)
#define PG8_LDA(dst, b, h) do { _Pragma("unroll") for (int m = 0; m < 4; ++m) _Pragma("unroll") for (int k = 0; k < 2; ++k) dst[m][k] = *(const PG8_LAS bf16x8*)(lds + PG8_SA(b, h) + aoff + m * 2048 + k * 1024); } while (0)
#define PG8_LDB(dst, b, h) do { _Pragma("unroll") for (int n = 0; n < 2; ++n) _Pragma("unroll") for (int k = 0; k < 2; ++k) dst[n][k] = *(const PG8_LAS bf16x8*)(lds + PG8_SB(b, h) + boff + n * 2048 + k * 1024); } while (0)
#define PG8_MMA(ai, bj, At, Bt) do { __builtin_amdgcn_s_setprio(1); _Pragma("unroll") for (int m = 0; m < 4; ++m) _Pragma("unroll") for (int n = 0; n < 2; ++n) _Pragma("unroll") for (int k = 0; k < 2; ++k) \
        acc[ai][bj][m][n] = __builtin_amdgcn_mfma_f32_16x16x32_bf16(Bt[n][k], At[m][k], acc[ai][bj][m][n], 0, 0, 0); __builtin_amdgcn_s_setprio(0); } while (0)
#define PG8_WAIT_V(n) asm volatile("s_waitcnt vmcnt(" #n ")" ::: "memory")
#define PG8_WAIT_L(n) asm volatile("s_waitcnt lgkmcnt(" #n ")" ::: "memory")
#define PG8_BAR __builtin_amdgcn_s_barrier()
#define PG8_SCHED __builtin_amdgcn_sched_barrier(0)
    Unit cur, nxt; int ui = 0;
    if (!S.next(0, cur)) return;
    f32x4 acc[2][2][4][2];
#pragma unroll
    for (int a = 0; a < 2; ++a)
#pragma unroll
        for (int b = 0; b < 2; ++b)
#pragma unroll
            for (int m = 0; m < 4; ++m)
#pragma unroll
                for (int n = 0; n < 2; ++n) acc[a][b][m][n] = (f32x4){0.f, 0.f, 0.f, 0.f};
    bf16x8 At[4][2], B0[2][2], B1[2][2];
    const char* cA = (const char*)g.A + (size_t)cur.pm * tstep; const char* cB = (const char*)g.Bt + (size_t)cur.pn * tstep;
    S.a_ready(cur);
    if constexpr (SP2) {
        PG8_STAGE(PG8_SB(0, 0), cB, voffB); PG8_STAGE(PG8_SB(0, 1), cB + hstep, voffB); PG8_STAGE(PG8_SA(0, 0), cA, voffA); PG8_STAGE(PG8_SA(0, 1), cA + hstep, voffA);
        if (wr == 1) PG8_BAR;
        PG8_WAIT_V(2); PG8_BAR;
        PG8_STAGE(PG8_SB(1, 0), cB + kstep, voffB); PG8_STAGE(PG8_SA(1, 0), cA + kstep, voffA); PG8_STAGE(PG8_SB(1, 1), cB + hstep + kstep, voffB);
        PG8_WAIT_V(6); PG8_BAR;
    } else {
        PG8_STAGE(PG8_SB(0, 0), cB, voffB); PG8_STAGE(PG8_SA(0, 0), cA, voffA); PG8_STAGE(PG8_SB(0, 1), cB + hstep, voffB); PG8_STAGE(PG8_SA(0, 1), cA + hstep, voffA);
        if (wr == 1) PG8_BAR;
        PG8_WAIT_V(4); PG8_BAR;
        PG8_STAGE(PG8_SB(1, 0), cB + kstep, voffB); PG8_STAGE(PG8_SA(1, 0), cA + kstep, voffA); PG8_STAGE(PG8_SB(1, 1), cB + hstep + kstep, voffB);
        PG8_WAIT_V(6); PG8_BAR;
    }
    for (;;) {
        const bool has_next = S.next(ui + 1, nxt);
        const char* nA = has_next ? (const char*)g.A + (size_t)nxt.pm * tstep : cA; const char* nB = has_next ? (const char*)g.Bt + (size_t)nxt.pn * tstep : cB;
        for (int t = 0; t < nt; t += 2) {
            const bool last = (t == nt - 2);
            const char* a1 = cA + (size_t)(t + 1) * kstep;
            const char* a2 = last ? nA : cA + (size_t)(t + 2) * kstep; const char* b2 = last ? nB : cB + (size_t)(t + 2) * kstep;
            const char* a3 = a2 + kstep; const char* b3 = b2 + kstep;
            if (last && has_next) S.a_ready(nxt);
            if constexpr (SP2) {
            PG8_LDB(B0, 0, 0); PG8_LDB(B1, 0, 1); PG8_SCHED; PG8_LDA(At, 0, 0); PG8_STAGE(PG8_SA(1, 1), a1 + hstep, voffA);
            PG8_WAIT_V(8); PG8_WAIT_L(0); PG8_BAR; PG8_MMA(0, 0, At, B0); PG8_MMA(0, 1, At, B1); PG8_BAR; PG8_SCHED;
            PG8_LDA(At, 0, 1); PG8_STAGE(PG8_SB(0, 0), b2, voffB); PG8_STAGE(PG8_SB(0, 1), b2 + hstep, voffB); PG8_STAGE(PG8_SA(0, 0), a2, voffA);
            PG8_WAIT_V(8); PG8_WAIT_L(0); PG8_BAR; PG8_MMA(1, 0, At, B0); PG8_MMA(1, 1, At, B1); PG8_BAR; PG8_SCHED;
            PG8_LDB(B0, 1, 0); PG8_LDB(B1, 1, 1); PG8_SCHED; PG8_LDA(At, 1, 0); PG8_STAGE(PG8_SA(0, 1), a2 + hstep, voffA);
            PG8_WAIT_V(8); PG8_WAIT_L(0); PG8_BAR; PG8_MMA(0, 0, At, B0); PG8_MMA(0, 1, At, B1); PG8_BAR; PG8_SCHED;
            PG8_LDA(At, 1, 1); PG8_STAGE(PG8_SB(1, 0), b3, voffB); PG8_STAGE(PG8_SB(1, 1), b3 + hstep, voffB); PG8_STAGE(PG8_SA(1, 0), a3, voffA);
            PG8_WAIT_V(8); PG8_WAIT_L(0); PG8_BAR; PG8_MMA(1, 0, At, B0); PG8_MMA(1, 1, At, B1); PG8_BAR; PG8_SCHED;
            } else {
            PG8_LDB(B0, 0, 0); PG8_SCHED; PG8_LDA(At, 0, 0); PG8_STAGE(PG8_SA(1, 1), a1 + hstep, voffA);
            PG8_WAIT_L(8); PG8_BAR; PG8_WAIT_L(0); PG8_MMA(0, 0, At, B0); PG8_BAR; PG8_SCHED;
            PG8_LDB(B1, 0, 1); PG8_STAGE(PG8_SB(0, 0), b2, voffB);
            PG8_BAR; PG8_WAIT_L(0); PG8_MMA(0, 1, At, B1); PG8_BAR;
            PG8_LDA(At, 0, 1); PG8_STAGE(PG8_SA(0, 0), a2, voffA);
            PG8_BAR; PG8_WAIT_L(0); PG8_MMA(1, 0, At, B0); PG8_BAR; PG8_SCHED;
            PG8_STAGE(PG8_SB(0, 1), b2 + hstep, voffB);
            PG8_WAIT_V(6); PG8_BAR; PG8_MMA(1, 1, At, B1); PG8_BAR;
            PG8_LDB(B0, 1, 0); PG8_SCHED; PG8_LDA(At, 1, 0); PG8_STAGE(PG8_SA(0, 1), a2 + hstep, voffA);
            PG8_WAIT_L(8); PG8_BAR; PG8_WAIT_L(0); PG8_MMA(0, 0, At, B0); PG8_BAR; PG8_SCHED;
            PG8_LDB(B1, 1, 1); PG8_STAGE(PG8_SB(1, 0), b3, voffB);
            PG8_BAR; PG8_WAIT_L(0); PG8_MMA(0, 1, At, B1); PG8_BAR;
            PG8_LDA(At, 1, 1); PG8_STAGE(PG8_SA(1, 0), a3, voffA);
            PG8_BAR; PG8_WAIT_L(0); PG8_MMA(1, 0, At, B0); PG8_BAR; PG8_SCHED;
            PG8_STAGE(PG8_SB(1, 1), b3 + hstep, voffB);
            PG8_WAIT_V(6); PG8_BAR; PG8_MMA(1, 1, At, B1); PG8_BAR;
            }
        }
        if constexpr (ALIGN_EPI) { if (wr == 0) PG8_BAR; }
        if constexpr (!Epi::AFTER_DRAIN) { E(acc, cur, wr, wc, fr, fq); S.done(cur); }
        if (!has_next) break;
#pragma unroll
        for (int a = 0; a < 2; ++a)
#pragma unroll
            for (int b = 0; b < 2; ++b)
#pragma unroll
                for (int m = 0; m < 4; ++m)
#pragma unroll
                    for (int n = 0; n < 2; ++n) acc[a][b][m][n] = (f32x4){0.f, 0.f, 0.f, 0.f};
        cur = nxt; cA = nA; cB = nB; ++ui;
        if constexpr (ALIGN_EPI) { if (wr == 1) PG8_BAR; }
    }
    PG8_WAIT_V(0);
    if constexpr (!ALIGN_EPI) { if (wr == 0) PG8_BAR; }
    PG8_BAR;
    if constexpr (Epi::AFTER_DRAIN) { E.fused(acc, cur, wr, wc, fr, fq, lds, wid, lane); S.done(cur); }
#undef PG8_SA
#undef PG8_SB
#undef PG8_STAGE
#undef PG8_LDA
#undef PG8_LDB
#undef PG8_MMA
#undef PG8_WAIT_V
#undef PG8_WAIT_L
#undef PG8_BAR
#undef PG8_SCHED
}
}

typedef unsigned short bf16_t;
typedef short bf16x8 __attribute__((ext_vector_type(8)));
typedef short s16x4 __attribute__((ext_vector_type(4)));
typedef float f32x4 __attribute__((ext_vector_type(4)));
typedef float f32x16 __attribute__((ext_vector_type(16)));
typedef unsigned u32x4 __attribute__((ext_vector_type(4)));
typedef unsigned u32x2 __attribute__((ext_vector_type(2)));
#define LAS __attribute__((address_space(3)))

constexpr int DM = 2048, SEQ = 16384, NMETA = 16, LTOK = SEQ + NMETA, MP = 16640, DFF = 8192;
constexpr int NIN_SRC = 6160, NIN = 6400, PW = 6144;
constexpr int NCH = 257;
constexpr int CFP = 16896;
constexpr float ALPHA = 1.4142135623730951f;
constexpr float LN_EPS = 1e-5f, RMS_EPS = 1e-6f;
constexpr int C_MQ = 0, C_MK = 512, C_MV = 1024, C_MO = 2048, C_FQ = 3072, C_FK = 4096, C_FV = 5120;

constexpr size_t MiB = 1u << 20;
constexpr size_t WS_CTL = 0, WS_ZS = 0x20000, WS_GM = 0x60000, WS_MPREV = 0x70000, WS_NLOC = 0x100000, WS_CF = 0x200000, WS_GATES = 0x300000;
constexpr size_t WS_WIN = 8 * MiB, WS_WOUT = 33 * MiB, WS_WUP = 41 * MiB, WS_WDOWN = 73 * MiB;
constexpr size_t WS_HB = 105 * MiB, WS_MIX = 170 * MiB, WS_PROJ = 235 * MiB, WS_CT = 430 * MiB, WS_U = 235 * MiB, WS_Z1 = 235 * MiB, WS_END = 495 * MiB;
static_assert((size_t)MP * PW * 2 <= 195 * MiB && (size_t)4 * NCH * 32768 * 2 <= 65 * MiB && (size_t)MP * DFF * 2 <= 260 * MiB && (size_t)MP * DM * 4 <= 195 * MiB, "ws map");

constexpr int LDS_BYTES = 139264;
constexpr int LDS_MISC = 138240;

__device__ __forceinline__ unsigned cvt_pk_bf16(float lo, float hi) { unsigned r; asm volatile("v_cvt_pk_bf16_f32 %0, %1, %2" : "=v"(r) : "v"(lo), "v"(hi)); return r; }
__device__ __forceinline__ float bf2f(unsigned short v) { return __uint_as_float(((unsigned)v) << 16); }
__device__ __forceinline__ float bflo(unsigned w) { return __uint_as_float(w << 16); }
__device__ __forceinline__ float bfhi(unsigned w) { return __uint_as_float(w & 0xffff0000u); }
__device__ __forceinline__ float fast_exp(float x) { return __builtin_amdgcn_exp2f(x * 1.4426950408889634f); }
__device__ __forceinline__ float logsigmoid(float x) { return fminf(x, 0.f) - log1pf(__expf(-fabsf(x))); }
__device__ __forceinline__ float sigmoidf(float x) { return 1.f / (1.f + __expf(-x)); }

struct Params {
    const float* in[17];
    float* out; unsigned char* ws;
    int ph_lo, ph_hi;
};

struct EpiProj {
    static constexpr bool PERM = true, AFTER_DRAIN = false;
    bf16_t* O;
    __device__ __forceinline__ void operator()(const pg8::f32x4 (&acc)[2][2][4][2], const pg8::Unit& u, int wr, int wc, int fr, int fq) const {
        const int row0 = NMETA + u.pm * 256 + wr * 64 + fr, col0 = u.pn * 256 + wc * 32 + 8 * fq;
#pragma unroll
        for (int ai = 0; ai < 2; ++ai)
#pragma unroll
            for (int m = 0; m < 4; ++m) { bf16_t* rowp = O + (size_t)(row0 + ai * 128 + m * 16) * PW + col0;
#pragma unroll
                for (int bj = 0; bj < 2; ++bj) { const pg8::f32x4 v0 = acc[ai][bj][m][0], v1 = acc[ai][bj][m][1];
                    u32x4 w; w.x = cvt_pk_bf16(v0[0], v0[1]); w.y = cvt_pk_bf16(v0[2], v0[3]); w.z = cvt_pk_bf16(v1[0], v1[1]); w.w = cvt_pk_bf16(v1[2], v1[3]);
                    *(u32x4*)(rowp + bj * 128) = w; } }
    }
};
struct EpiSqRelu {
    static constexpr bool PERM = true, AFTER_DRAIN = false;
    bf16_t* O;
    __device__ __forceinline__ void operator()(const pg8::f32x4 (&acc)[2][2][4][2], const pg8::Unit& u, int wr, int wc, int fr, int fq) const {
        const int row0 = NMETA + u.pm * 256 + wr * 64 + fr, col0 = u.pn * 256 + wc * 32 + 8 * fq;
#pragma unroll
        for (int ai = 0; ai < 2; ++ai)
#pragma unroll
            for (int m = 0; m < 4; ++m) { bf16_t* rowp = O + (size_t)(row0 + ai * 128 + m * 16) * DFF + col0;
#pragma unroll
                for (int bj = 0; bj < 2; ++bj) { pg8::f32x4 v0 = acc[ai][bj][m][0], v1 = acc[ai][bj][m][1];
#pragma unroll
                    for (int i = 0; i < 4; ++i) { const float a = fmaxf(v0[i], 0.f), b = fmaxf(v1[i], 0.f); v0[i] = a * a; v1[i] = b * b; }
                    u32x4 w; w.x = cvt_pk_bf16(v0[0], v0[1]); w.y = cvt_pk_bf16(v0[2], v0[3]); w.z = cvt_pk_bf16(v1[0], v1[1]); w.w = cvt_pk_bf16(v1[2], v1[3]);
                    *(u32x4*)(rowp + bj * 128) = w; } }
    }
};
template <int MODE> struct EpiRes {
    static constexpr bool PERM = true, AFTER_DRAIN = false;
    const bf16_t* H; float* Z;
    __device__ __forceinline__ void operator()(const pg8::f32x4 (&acc)[2][2][4][2], const pg8::Unit& u, int wr, int wc, int fr, int fq) const {
        const int row0 = u.pm * 256 + wr * 64 + fr, col0 = u.pn * 256 + wc * 32 + 8 * fq;
#pragma unroll
        for (int ai = 0; ai < 2; ++ai)
#pragma unroll
            for (int m = 0; m < 4; ++m) { const int row = row0 + ai * 128 + m * 16;
                float* zr = Z + (size_t)(row + (MODE == 0 ? NMETA : 0)) * DM;
                const bf16_t* hr = H + (size_t)(row + NMETA) * DM;
#pragma unroll
                for (int bj = 0; bj < 2; ++bj) { const int c = col0 + bj * 128; const u32x4 hw = *(const u32x4*)(hr + c);
                    pg8::f32x4 a0 = acc[ai][bj][m][0], a1 = acc[ai][bj][m][1];
                    a0[0] += ALPHA * bflo(hw.x); a0[1] += ALPHA * bfhi(hw.x); a0[2] += ALPHA * bflo(hw.y); a0[3] += ALPHA * bfhi(hw.y);
                    a1[0] += ALPHA * bflo(hw.z); a1[1] += ALPHA * bfhi(hw.z); a1[2] += ALPHA * bflo(hw.w); a1[3] += ALPHA * bfhi(hw.w);
                    *(pg8::f32x4*)(zr + c) = a0; *(pg8::f32x4*)(zr + c + 4) = a1; } }
    }
};

template <int KSPLIT, class Epi>
__device__ __forceinline__ void skinny_gemm(const bf16_t* __restrict__ A, int lda, const bf16_t* __restrict__ Wt, int K, int ntiles, char* lds, const Epi& E) {
    int tidl_ = threadIdx.x; asm volatile("" : "+v"(tidl_));
    const int tid = tidl_, wid = __builtin_amdgcn_readfirstlane(tid >> 6), lane = tid & 63, i = lane & 15, kq = lane >> 4;
    const int total = ntiles * KSPLIT, klen = K / KSPLIT;
    for (int base = 0; base < total; base += (int)gridDim.x * 8) {
        const int slot = base + (int)blockIdx.x * 8 + wid, tile = slot / KSPLIT, ks = slot % KSPLIT;
        const bool act = slot < total;
        f32x4 acc = {0.f, 0.f, 0.f, 0.f};
        if (act) {
            const bf16_t* ap = A + (size_t)i * lda + ks * klen + 8 * kq;
            const bf16_t* wp = Wt + (size_t)(tile * 16 + i) * K + ks * klen + 8 * kq;
            for (int k = 0; k < klen; k += 256) {
                bf16x8 a[8], w[8];
#pragma unroll
                for (int j = 0; j < 8; ++j) { a[j] = *(const bf16x8*)(ap + k + 32 * j); w[j] = *(const bf16x8*)(wp + k + 32 * j); }
#pragma unroll
                for (int j = 0; j < 8; ++j) acc = __builtin_amdgcn_mfma_f32_16x16x32_bf16(w[j], a[j], acc, 0, 0, 0);
            }
        }
        if (KSPLIT > 1) {
            float* red = (float*)lds;
            if (act) *(f32x4*)(red + wid * 256 + lane * 4) = acc;
            __syncthreads();
            if (act && ks == 0) {
#pragma unroll
                for (int j = 1; j < KSPLIT; ++j) acc += *(const f32x4*)(red + (wid + j) * 256 + lane * 4); }
            __syncthreads();
        }
        if (act && ks == 0) E(tile, i, kq, acc);
    }
}
struct SkProj { bf16_t* O; __device__ __forceinline__ void operator()(int tile, int j, int q, f32x4 a) const {
    u32x2 w; w.x = cvt_pk_bf16(a[0], a[1]); w.y = cvt_pk_bf16(a[2], a[3]); *(u32x2*)(O + (size_t)j * PW + tile * 16 + 4 * q) = w; } };
struct SkGates { float* G; __device__ __forceinline__ void operator()(int tile, int j, int q, f32x4 a) const {
    float* g = G + (size_t)(tile * 16 + 4 * q) * 16 + j; g[0] = a[0]; g[16] = a[1]; g[32] = a[2]; g[48] = a[3]; } };
struct SkSqRelu { bf16_t* O; __device__ __forceinline__ void operator()(int tile, int j, int q, f32x4 a) const {
#pragma unroll
    for (int c = 0; c < 4; ++c) { const float r = fmaxf(a[c], 0.f); a[c] = r * r; }
    u32x2 w; w.x = cvt_pk_bf16(a[0], a[1]); w.y = cvt_pk_bf16(a[2], a[3]); *(u32x2*)(O + (size_t)j * DFF + tile * 16 + 4 * q) = w; } };
struct SkRes { const bf16_t* H; float* Z; __device__ __forceinline__ void operator()(int tile, int j, int q, f32x4 a) const {
    const int c = tile * 16 + 4 * q; const u32x2 hw = *(const u32x2*)(H + (size_t)j * DM + c);
    a[0] += ALPHA * bflo(hw.x); a[1] += ALPHA * bfhi(hw.x); a[2] += ALPHA * bflo(hw.y); a[3] += ALPHA * bfhi(hw.y);
    *(f32x4*)(Z + (size_t)j * DM + c) = a; } };

namespace fox {
constexpr int D = 128, NW = 8, QBLK = 32, KVBLK = 64, QB = 256;
constexpr int SHM_V = KVBLK * D * 2, SHM_K = KVBLK * D * 2;
constexpr int L_WS = 2 * SHM_V + 2 * SHM_K, L_BIAS = L_WS + NW * 64 * 4;
constexpr int SKV = 16448;
constexpr int NQB = 65, NHEAD = 8;
constexpr float SCALE = 0.08838834764831845f, INV_SCALE = 11.313708498984761f;
constexpr float THR = 8.f;
constexpr unsigned WBIG = 1u << 30;
constexpr float TSKIP = 30.f;
static_assert(L_BIAS + (SKV + 256) * 4 <= LDS_MISC, "attention LDS");

#define KSWZ(row, colB) ((row) * 256 + ((colB) ^ (((row) & 7) << 4)))
#define SBAR() __builtin_amdgcn_sched_barrier(0)
__device__ __forceinline__ int v_st(int k, int c) { const int kk = (k & ~0xC) | ((k & 4) << 1) | ((k & 8) >> 1); return ((kk >> 3) * 4 + (c >> 5)) * 512 + ((kk & 7) * 32 + (c & 31)) * 2; }
__device__ __forceinline__ int v_rd_base(int lane) { return ((lane & 3) << 3) | (((lane >> 2) & 3) << 6) | (((lane >> 4) & 1) << 5) | (((lane >> 5) & 1) << 8); }
constexpr int v_rd_off(int d0, int ks, int half) { return d0 * 512 + ks * 4096 + half * 2048; }
__device__ __forceinline__ int crow(int r, int hi) { return (r & 3) + 8 * (r >> 2) + 4 * hi; }
__device__ __forceinline__ bf16x8 load8(const bf16_t* p) { return *reinterpret_cast<const bf16x8*>(p); }
__device__ __forceinline__ void mask_tile(f32x16& p0, f32x16& p1, int dq, unsigned W) {
    const float NEG = -__builtin_inff();
#pragma unroll
    for (int r = 0; r < 16; ++r) {
        const int c = (r & 3) + 8 * (r >> 2);
        if ((unsigned)(dq - c) >= W) p0[r] = NEG;
        if ((unsigned)(dq - c - 32) >= W) p1[r] = NEG;
    }
}
__device__ __forceinline__ void partialSM(f32x16& p0, f32x16& p1, float& m_reg, float& mn, float& alpha) {
    float pmax = p0[0];
#pragma unroll
    for (int r = 1; r < 16; ++r) pmax = fmaxf(pmax, p0[r]);
#pragma unroll
    for (int r = 0; r < 16; ++r) pmax = fmaxf(pmax, p1[r]);
    { auto rr = __builtin_amdgcn_permlane32_swap(__float_as_uint(pmax), __float_as_uint(pmax), false, false);
      pmax = fmaxf(__uint_as_float(rr[0]), __uint_as_float(rr[1])); }
    constexpr float C2 = 1.4426950408889634f * SCALE;
    if (__builtin_expect(__all((pmax - m_reg) * SCALE <= THR), 1)) { mn = m_reg; alpha = 1.f; }
    else { mn = fmaxf(m_reg, pmax); alpha = __builtin_amdgcn_exp2f((m_reg - mn) * C2); m_reg = mn; }
    const float mnL = -mn * C2;
#pragma unroll
    for (int r = 0; r < 16; ++r) p0[r] = fmaf(p0[r], C2, mnL);
#pragma unroll
    for (int r = 0; r < 16; ++r) p1[r] = fmaf(p1[r], C2, mnL);
#pragma unroll
    for (int r = 0; r < 16; ++r) p0[r] = __builtin_amdgcn_exp2f(p0[r]);
}
__device__ __forceinline__ void finishSM(f32x16& p0, f32x16& p1, float alpha, float& l_reg, bf16x8& pa0, bf16x8& pa1, bf16x8& pa2, bf16x8& pa3) {
#pragma unroll
    for (int r = 0; r < 16; ++r) p1[r] = __builtin_amdgcn_exp2f(p1[r]);
    float ps = 0;
#pragma unroll
    for (int r = 0; r < 16; ++r) ps += p0[r];
#pragma unroll
    for (int r = 0; r < 16; ++r) ps += p1[r];
    { auto rr = __builtin_amdgcn_permlane32_swap(__float_as_uint(ps), __float_as_uint(ps), false, false);
      ps = __uint_as_float(rr[0]) + __uint_as_float(rr[1]); }
    l_reg = l_reg * alpha + ps;
#define PK4(P, B_, OUT) do { unsigned a0 = cvt_pk_bf16(P[B_+0], P[B_+1]), a1 = cvt_pk_bf16(P[B_+2], P[B_+3]);                          \
        unsigned b0 = cvt_pk_bf16(P[B_+4], P[B_+5]), b1 = cvt_pk_bf16(P[B_+6], P[B_+7]);                                             \
        auto r0 = __builtin_amdgcn_permlane32_swap(a0, b0, false, false); auto r1 = __builtin_amdgcn_permlane32_swap(a1, b1, false, false); \
        u32x4 w = {r0[0], r1[0], r0[1], r1[1]}; OUT = *reinterpret_cast<bf16x8*>(&w); } while (0)
    PK4(p0, 0, pa0); PK4(p0, 8, pa1); PK4(p1, 0, pa2); PK4(p1, 8, pa3);
#undef PK4
}
template <int KB>
__device__ __forceinline__ void qkt(f32x16& p0, f32x16& p1, const char* K_lds, int r32, int hi, const bf16x8* qr, const float* btile) {
#pragma unroll
    for (int j = 0; j < 4; ++j) { const f32x4 a = *(const f32x4*)(btile + 8 * j), b = *(const f32x4*)(btile + 32 + 8 * j);
        p0[4 * j] = a[0]; p0[4 * j + 1] = a[1]; p0[4 * j + 2] = a[2]; p0[4 * j + 3] = a[3];
        p1[4 * j] = b[0]; p1[4 * j + 1] = b[1]; p1[4 * j + 2] = b[2]; p1[4 * j + 3] = b[3]; }
    const char* kb[4];
#pragma unroll
    for (int dd = 0; dd < 4; ++dd) kb[dd] = K_lds + KB * SHM_K + KSWZ(r32, (dd * 16 + hi * 8) * 2);
#pragma unroll
    for (int d0 = 0; d0 < 8; ++d0) { const char* a = kb[d0 & 3] + (d0 >> 2) * 128;
        bf16x8 b0 = *reinterpret_cast<const bf16x8*>(a);
        bf16x8 b1 = *reinterpret_cast<const bf16x8*>(a + 32 * 256);
        p0 = __builtin_amdgcn_mfma_f32_32x32x16_bf16(b0, qr[d0], p0, 0, 0, 0);
        p1 = __builtin_amdgcn_mfma_f32_32x32x16_bf16(b1, qr[d0], p1, 0, 0, 0); }
}
template <int VB>
__device__ __forceinline__ void pv_tile(f32x16* o, int vb0, bf16x8 pa0, bf16x8 pa1, bf16x8 pa2, bf16x8 pa3) {
#define TRRD(dst, off) asm volatile("ds_read_b64_tr_b16 %0, %1 offset:%2" : "=&v"(dst) : "v"(vb0), "i"(off) : "memory")
#define PV_D0(d0) do { s16x4 l0, l1, l2, l3, h0, h1, h2, h3; constexpr int b_ = VB * SHM_V + v_rd_off(d0, 0, 0); \
        TRRD(l0, b_); TRRD(h0, b_ + 2048); TRRD(l1, b_ + 4096); TRRD(h1, b_ + 6144); TRRD(l2, b_ + 8192); TRRD(h2, b_ + 10240); TRRD(l3, b_ + 12288); TRRD(h3, b_ + 14336); \
        asm volatile("s_waitcnt lgkmcnt(0)" ::: "memory"); SBAR();   \
        o[d0] = __builtin_amdgcn_mfma_f32_32x32x16_bf16(pa0, (bf16x8){l0[0], l0[1], l0[2], l0[3], h0[0], h0[1], h0[2], h0[3]}, o[d0], 0, 0, 0);   \
        o[d0] = __builtin_amdgcn_mfma_f32_32x32x16_bf16(pa1, (bf16x8){l1[0], l1[1], l1[2], l1[3], h1[0], h1[1], h1[2], h1[3]}, o[d0], 0, 0, 0);   \
        o[d0] = __builtin_amdgcn_mfma_f32_32x32x16_bf16(pa2, (bf16x8){l2[0], l2[1], l2[2], l2[3], h2[0], h2[1], h2[2], h2[3]}, o[d0], 0, 0, 0);   \
        o[d0] = __builtin_amdgcn_mfma_f32_32x32x16_bf16(pa3, (bf16x8){l3[0], l3[1], l3[2], l3[3], h3[0], h3[1], h3[2], h3[3]}, o[d0], 0, 0, 0); } while (0)
    PV_D0(0); PV_D0(1); PV_D0(2); PV_D0(3);
#undef PV_D0
#undef TRRD
}
struct BlockRef { const bf16_t* Q; const bf16_t* K; bf16_t* O; int P0; int head; int jlo; };
constexpr int VOFF = C_FV - C_FK;
struct Seam { bf16x8 qr[8]; bf16x8 st_v0, st_v1, st_k0, st_k1; };
#define VMW() asm volatile("s_waitcnt vmcnt(0)" ::: "memory")
#define VMWN(n) asm volatile("s_waitcnt vmcnt(%0)" :: "i"(n) : "memory")
#define SLOAD_H(Kp, k0) do { const bf16_t* kb__ = (Kp) + (size_t)(k0) * PW;     \
                         S.st_v0 = load8(kb__ + voff0 + VOFF); S.st_v1 = load8(kb__ + voff1 + VOFF);              \
                         S.st_k0 = load8(kb__ + voff0); S.st_k1 = load8(kb__ + voff1); } while (0)
#define SWRITE_HK(bf) do { *(bf16x8*)(K_lds + (bf) * SHM_K + kws) = S.st_k0; *(bf16x8*)(K_lds + (bf) * SHM_K + kws + 32 * 256) = S.st_k1; } while (0)
#define SWRITE_HV(bf) do { *(bf16x8*)(V_lds + (bf) * SHM_V + vst0) = S.st_v0; *(bf16x8*)(V_lds + (bf) * SHM_V + vst1) = S.st_v1; } while (0)
#define SWRITE_H(bf) do { SWRITE_HV(bf); SWRITE_HK(bf); } while (0)
__device__ __forceinline__ void fox_prime(const BlockRef& cur, char* lds, Seam& S) {
    int tidl_ = threadIdx.x; asm volatile("" : "+v"(tidl_));
    const int tid = tidl_, wid = __builtin_amdgcn_readfirstlane(tid >> 6), lane = tid & 63, r32 = lane & 31, hi = lane >> 5;
    const int sr = tid >> 4, sc = (tid & 15) * 8, kws = KSWZ(sr, sc * 2); char* K_lds = lds + 2 * SHM_V;
    const unsigned voff0 = (unsigned)(sr * PW + sc), voff1 = voff0 + 32u * PW, voffq = (unsigned)(r32 * PW + hi * 8);
    { const bf16_t* qb__ = cur.Q + (size_t)(wid * QBLK) * PW;
#pragma unroll
    for (int d0 = 0; d0 < 8; ++d0) S.qr[d0] = load8(qb__ + voffq + d0 * 16); }
    SLOAD_H(cur.K, cur.jlo * KVBLK); VMW(); SWRITE_HK(0);
    __syncthreads();
}
__device__ __forceinline__ int fox_take(unsigned* ctr, int xcc) {
    for (int hh = 0; hh <= NHEAD; ++hh) { const int hd = hh == 0 ? xcc : NHEAD - hh;
        if (hh && hd == xcc) continue;
        if (__hip_atomic_load(ctr + hd, __ATOMIC_RELAXED, __HIP_MEMORY_SCOPE_AGENT) >= (unsigned)NQB) continue;
        const unsigned i = atomicAdd(ctr + hd, 1u); if (i < (unsigned)NQB) return hd * 256 + (NQB - 1 - (int)i); }
    return -1;
}
__device__ __forceinline__ int fox_jlo(const float* __restrict__ CF, const unsigned* __restrict__ nrm, int head, int P0) {
    int zv = 0; asm volatile("" : "+v"(zv));
    const float* cf = CF + (size_t)head * CFP;
    const int dk = (int)nrm[128 + head * 80 + (P0 >> 8) + zv]; const float dmin = __uint_as_float((unsigned)(dk ^ ((dk >> 31) & 0x7fffffff)));
    const float B = sqrtf(__uint_as_float(nrm[head * 2 + zv]) * __uint_as_float(nrm[head * 2 + 1 + zv])) * SCALE + TSKIP - dmin;
    const float thr = cf[P0 + zv] + B;
    int jh = (P0 + QB - 1) / KVBLK + 1; if (jh > SKV / KVBLK) jh = SKV / KVBLK;
    const int j = threadIdx.x;
    const int flag = (j < jh) && (cf[64 * j + 63] > thr);
    return __builtin_amdgcn_readfirstlane(__syncthreads_count(flag));
}
__device__ __forceinline__ void fox_ref(int code, BlockRef& R, bf16_t* PROJ, bf16_t* MIX) {
    const int qb = code & 255, hd = code >> 8; R.P0 = qb * 256; R.head = hd; R.Q = PROJ + (size_t)R.P0 * PW + C_FQ + hd * 128;
    R.K = PROJ + C_FK + hd * 128; R.O = MIX + (size_t)R.P0 * DM + 1024 + hd * 128;
}
__device__ __forceinline__ bool fox_block(const BlockRef& cur, BlockRef& nxt, unsigned* ctr, const unsigned* nrm, bf16_t* PROJ, bf16_t* MIX, char* lds, Seam& S, const float* __restrict__ CF, const float* __restrict__ fnorm) {
    int tid_ = threadIdx.x; asm volatile("" : "+v"(tid_));
    const int tid = tid_, wid = __builtin_amdgcn_readfirstlane(tid >> 6), lane = tid & 63, r32 = lane & 31, hi = lane >> 5;
    int j_hi = (cur.P0 + QB - 1) / KVBLK + 1; if (j_hi > SKV / KVBLK) j_hi = SKV / KVBLK;
    const int j_lo = cur.jlo, NT = j_hi - j_lo;
    float* bias = (float*)(lds + L_BIAS);
    { const float* cf = CF + (size_t)cur.head * CFP; int zv = 0; asm volatile("" : "+v"(zv)); const float cref = cf[cur.P0 + zv]; const int nk = NT * KVBLK; const float* cfl = cf + j_lo * KVBLK;
      for (int s = tid; s < nk; s += 512) bias[s] = (cref - cfl[s]) * INV_SCALE;
      __syncthreads(); }
    const float* bt = bias + 4 * hi;
    const int qlo = cur.P0 + wid * QBLK, qm = qlo + r32 - 4 * hi;
    char* V_lds = lds; char* K_lds = lds + 2 * SHM_V;
    float* ws = (float*)(lds + L_WS) + wid * 64; float* li_l = ws, * al_l = ws + 32;
    float m_reg = -1e30f, l_reg = 0; f32x16 o[4] = {};
    const int sr = tid >> 4, sc = (tid & 15) * 8, vst0 = v_st(sr, sc), vst1 = v_st(32 + sr, sc), kws = KSWZ(sr, sc * 2);
    const int vb0 = (int)(uintptr_t)V_lds + v_rd_base(lane);
    const bf16_t* Kh = cur.K;
    const unsigned voff0 = (unsigned)(sr * PW + sc), voff1 = voff0 + 32u * PW, voffq = (unsigned)(r32 * PW + hi * 8);
#define RESC(a) do { if (__any((a) < 1.f)) { if (hi == 0) al_l[r32] = (a); asm volatile("s_waitcnt lgkmcnt(0)" ::: "memory");              \
                     _Pragma("unroll") for (int d_ = 0; d_ < 4; ++d_) _Pragma("unroll") for (int r = 0; r < 16; ++r) o[d_][r] *= al_l[crow(r, hi)]; } } while (0)
#define KBASE(t) ((j_lo + (t)) * KVBLK)
#define MASKT(P0_, P1_, t) do { const int kb_ = KBASE(t); if (kb_ + KVBLK - 1 > qlo) mask_tile(P0_, P1_, qm - kb_, WBIG); } while (0)
#define SEAM_K0() do { VMWN(8); SWRITE_HK(0); SBAR(); } while (0)
    f32x16 pA0, pA1, pB0, pB1; float mnA, mnB, alA, alB; bf16x8 pa0, pa1, pa2, pa3;
    SWRITE_HV(0); SBAR();
    if (NT > 1) SLOAD_H(Kh, KBASE(1));
    SBAR(); qkt<0>(pA0, pA1, K_lds, r32, hi, S.qr, bt);
    MASKT(pA0, pA1, 0); partialSM(pA0, pA1, m_reg, mnA, alA);
    if (NT > 1) { VMW(); SWRITE_H(1); }
    __syncthreads();
#define HALF_STEP(PX0, PX1, mnX, alX, PY0, PY1, alY, t, KB, VB, SB) do {                                                      \
        SBAR(); qkt<KB>(PX0, PX1, K_lds, r32, hi, S.qr, bt + (t) * KVBLK);                                                       \
        finishSM(PY0, PY1, alY, l_reg, pa0, pa1, pa2, pa3); SBAR();                                                           \
        if ((t) + 1 < NT) { SLOAD_H(Kh, KBASE((t) + 1)); SBAR(); }                                                        \
        pv_tile<VB>(o, vb0, pa0, pa1, pa2, pa3); MASKT(PX0, PX1, (t)); partialSM(PX0, PX1, m_reg, mnX, alX);                  \
        __syncthreads();                                                                                                      \
        if ((t) + 1 < NT) { VMW(); SWRITE_H(SB); }                                                                            \
        RESC(alX); __syncthreads(); } while (0)
    for (int t = 1; t + 1 < NT; t += 2) {
        HALF_STEP(pB0, pB1, mnB, alB, pA0, pA1, alA, t, 1, 0, 0);
        HALF_STEP(pA0, pA1, mnA, alA, pB0, pB1, alB, t + 1, 0, 1, 1);
    }
    const bool even = (NT & 1) == 0;
    if (even) { SBAR(); qkt<1>(pB0, pB1, K_lds, r32, hi, S.qr, bt + (NT - 1) * KVBLK); SBAR(); }
    bool more;
    { volatile int* slot = (volatile int*)(lds + LDS_MISC);
      if (tid == 0) { const unsigned i_ = atomicAdd(ctr + cur.head, 1u); *slot = i_ < (unsigned)NQB ? cur.head * 256 + (NQB - 1 - (int)i_) : -1; }
      __syncthreads();
      const int ni = __builtin_amdgcn_readfirstlane(*slot);
      more = ni >= 0;
      if (more) { fox_ref(ni, nxt, PROJ, MIX); nxt.jlo = fox_jlo(CF, nrm, nxt.head, nxt.P0); } else nxt = cur; }
    SLOAD_H(nxt.K, nxt.jlo * KVBLK); SBAR();
    { const bf16_t* qb__ = nxt.Q + (size_t)(wid * QBLK) * PW;
#pragma unroll
    for (int d0 = 0; d0 < 8; ++d0) S.qr[d0] = load8(qb__ + voffq + d0 * 16); }
    SBAR();
    finishSM(pA0, pA1, alA, l_reg, pa0, pa1, pa2, pa3); SBAR();
    pv_tile<0>(o, vb0, pa0, pa1, pa2, pa3);
    if (even) { MASKT(pB0, pB1, NT - 1); partialSM(pB0, pB1, m_reg, mnB, alB); __syncthreads(); RESC(alB);
        finishSM(pB0, pB1, alB, l_reg, pa0, pa1, pa2, pa3); SBAR(); pv_tile<1>(o, vb0, pa0, pa1, pa2, pa3); }
    SBAR(); SEAM_K0();
    if (hi == 0) li_l[r32] = l_reg; asm volatile("s_waitcnt lgkmcnt(0)" ::: "memory");
    float rs[16];
#pragma unroll
    for (int r = 0; r < 16; ++r) { const float rl = __builtin_amdgcn_rcpf(li_l[crow(r, hi)]); float a = 0.f;
#pragma unroll
        for (int d0 = 0; d0 < 4; ++d0) { const float v = o[d0][r] * rl; o[d0][r] = v; a += v * v; }
        a += __shfl_xor(a, 1); a += __shfl_xor(a, 2); a += __shfl_xor(a, 4); a += __shfl_xor(a, 8); a += __shfl_xor(a, 16);
        rs[r] = rsqrtf(a * (1.f / 128.f) + RMS_EPS); }
    float gn[4];
#pragma unroll
    for (int d0 = 0; d0 < 4; ++d0) gn[d0] = fnorm[cur.head * 128 + d0 * 32 + r32];
    bf16_t* Ow = cur.O + (size_t)(wid * QBLK) * DM;
#pragma unroll
    for (int r = 0; r < 16; ++r) { const int orow = crow(r, hi);
#pragma unroll
        for (int d0 = 0; d0 < 4; ++d0) { const float v = o[d0][r] * rs[r] * gn[d0];
            const float vn = __shfl_xor(v, 1);
            if ((r32 & 1) == 0) *(unsigned*)(Ow + (size_t)orow * DM + d0 * 32 + r32) = cvt_pk_bf16(v, vn); } }
    __syncthreads();
    return more;
#undef RESC
#undef KBASE
#undef MASKT
#undef SEAM_K0
#undef HALF_STEP
}
#undef VMW
#undef VMWN
#undef SLOAD_H
#undef SWRITE_HK
#undef SWRITE_HV
#undef SWRITE_H
}

__device__ __forceinline__ float wave_sum(float v) {
#pragma unroll
    for (int o = 1; o < 64; o <<= 1) v += __shfl_xor(v, o);
    return v;
}
__device__ __forceinline__ float wave_max(float v) {
#pragma unroll
    for (int o = 1; o < 64; o <<= 1) v = fmaxf(v, __shfl_xor(v, o));
    return v;
}
__device__ __forceinline__ float wave_scan_add(float x, int lane) {
#pragma unroll
    for (int o = 1; o < 64; o <<= 1) { const float y = __shfl_up(x, o); if (lane >= o) x += y; }
    return x;
}
__device__ __forceinline__ float wave_scan_max(float x, int lane) {
#pragma unroll
    for (int o = 1; o < 64; o <<= 1) { const float y = __shfl_up(x, o); if (lane >= o) x = fmaxf(x, y); }
    return x;
}
__device__ __forceinline__ int fetch_item(unsigned* ctr, char* lds) {
    volatile int* slot = (volatile int*)(lds + LDS_MISC);
    if (threadIdx.x == 0) *slot = (int)atomicAdd(ctr, 1u);
    __syncthreads();
    const int v = __builtin_amdgcn_readfirstlane(*slot);
    __syncthreads();
    return v;
}

__device__ __forceinline__ void signal_done(unsigned* ctr, unsigned n = 1u) {
    asm volatile("s_waitcnt vmcnt(0)" ::: "memory");
    __syncthreads();
    if (threadIdx.x == 0) {
        __builtin_amdgcn_fence(__ATOMIC_RELEASE, "agent");
        asm volatile("s_waitcnt vmcnt(0)" ::: "memory");
        __hip_atomic_fetch_add(ctr, n, __ATOMIC_RELAXED, __HIP_MEMORY_SCOPE_AGENT);
    }
}
__device__ __forceinline__ void wait_count(unsigned* ctr, unsigned want) {
    if (threadIdx.x == 0) {
        unsigned sp = 0;
        while (__hip_atomic_load(ctr, __ATOMIC_RELAXED, __HIP_MEMORY_SCOPE_AGENT) < want) { __builtin_amdgcn_s_sleep(4); if (++sp > (1u << 22)) break; }
        __builtin_amdgcn_fence(__ATOMIC_ACQUIRE, "agent");
        asm volatile("s_waitcnt vmcnt(0)" ::: "memory");
    }
    __syncthreads();
}

__device__ __forceinline__ void transpose_item(const float* __restrict__ W, int K, int N, int nblk, bf16_t* __restrict__ WT, int mode, float* scr, int item, int lane) {
    const int kb = item / nblk, nb = item % nblk, k0 = 64 * kb, n0 = 32 * nb;
    const int n = n0 + (lane & 31); int src = n;
    if (mode) src = n < 2048 ? n : (n < 6144 ? n + 8 : (n < 6152 ? n - 6144 + 2048 : (n < 6160 ? n : -1)));
    float wv[32];
#pragma unroll
    for (int i = 0; i < 32; ++i) { const int kk = 2 * i + (lane >> 5); wv[i] = src >= 0 ? W[(size_t)(k0 + kk) * N + src] : 0.f; }
#pragma unroll
    for (int i = 0; i < 32; ++i) { const int kk = 2 * i + (lane >> 5); scr[kk * 33 + (lane & 31)] = wv[i]; }
    asm volatile("s_waitcnt lgkmcnt(0)" ::: "memory");
    const int c = lane & 7;
#pragma unroll
    for (int j = 0; j < 4; ++j) { const int nn = (lane >> 3) + 8 * j; const float* s = scr + (8 * c) * 33 + nn;
        u32x4 o; o.x = cvt_pk_bf16(s[0 * 33], s[1 * 33]); o.y = cvt_pk_bf16(s[2 * 33], s[3 * 33]); o.z = cvt_pk_bf16(s[4 * 33], s[5 * 33]); o.w = cvt_pk_bf16(s[6 * 33], s[7 * 33]);
        *(u32x4*)(WT + (size_t)(n0 + nn) * K + k0 + 8 * c) = o; }
    asm volatile("s_waitcnt lgkmcnt(0)" ::: "memory");
}
__device__ __forceinline__ void convert_weights(const Params& P, int l, int part, char* lds, int gw, int NGW, int wid, int lane) {
    float* scr = (float*)(lds + wid * 8704);
    const float* w_in = P.in[2] + (size_t)l * DM * NIN_SRC; const float* w_out = P.in[10] + (size_t)l * DM * DM;
    const float* w_up = P.in[13] + (size_t)l * DM * DFF; const float* w_down = P.in[14] + (size_t)l * DFF * DM;
    bf16_t* WinT = (bf16_t*)(P.ws + WS_WIN); bf16_t* WoutT = (bf16_t*)(P.ws + WS_WOUT); bf16_t* WupT = (bf16_t*)(P.ws + WS_WUP); bf16_t* WdownT = (bf16_t*)(P.ws + WS_WDOWN);
    constexpr int I_IN = (DM / 64) * (NIN / 32), I_OUT = (DM / 64) * (DM / 32), I_UP = (DM / 64) * (DFF / 32), I_DOWN = (DFF / 64) * (DM / 32);
    const int lo = part == 2 ? I_IN + I_OUT : 0, hi = part == 1 ? I_IN + I_OUT : I_IN + I_OUT + I_UP + I_DOWN;
    for (int it = lo + gw; it < hi; it += NGW) {
        int r = it;
        if (r < I_IN) { transpose_item(w_in, DM, NIN_SRC, NIN / 32, WinT, 1, scr, r, lane); continue; } r -= I_IN;
        if (r < I_OUT) { transpose_item(w_out, DM, DM, DM / 32, WoutT, 0, scr, r, lane); continue; } r -= I_OUT;
        if (r < I_UP) { transpose_item(w_up, DM, DFF, DFF / 32, WupT, 0, scr, r, lane); continue; } r -= I_UP;
        transpose_item(w_down, DFF, DM, DM / 32, WdownT, 0, scr, r, lane);
    }
}

__device__ __forceinline__ void zero_pad_rows(const Params& P) {
    u32x4* p = (u32x4*)((bf16_t*)(P.ws + WS_PROJ) + (size_t)LTOK * PW); const int n = (MP - LTOK) * PW / 8;
    for (int i = blockIdx.x * 512 + threadIdx.x; i < n; i += gridDim.x * 512) p[i] = (u32x4){0u, 0u, 0u, 0u};
    u32x4* g = (u32x4*)((float*)(P.ws + WS_GATES) + (size_t)LTOK * 16); const int m = (MP - LTOK) * 16 / 4;
    for (int i = blockIdx.x * 512 + threadIdx.x; i < m; i += gridDim.x * 512) g[i] = (u32x4){0u, 0u, 0u, 0u};
}

__device__ __forceinline__ void ln_load(f32x4 (&v)[8], const float* z, int lane) {
#pragma unroll
    for (int j = 0; j < 8; ++j) v[j] = ((const f32x4*)z)[lane + 64 * j];
}
__device__ __forceinline__ void ln_apply(f32x4 (&v)[8], const float* __restrict__ g, const float* __restrict__ b, bf16_t* hb, float* fo, int lane) {
    float s = 0.f;
#pragma unroll
    for (int j = 0; j < 8; ++j) s += (v[j][0] + v[j][1]) + (v[j][2] + v[j][3]);
    const float mean = wave_sum(s) * (1.f / DM); float q = 0.f;
#pragma unroll
    for (int j = 0; j < 8; ++j) { v[j] = v[j] - mean; q += (v[j][0] * v[j][0] + v[j][1] * v[j][1]) + (v[j][2] * v[j][2] + v[j][3] * v[j][3]); }
    const float rstd = rsqrtf(wave_sum(q) * (1.f / DM) + LN_EPS);
#pragma unroll
    for (int j = 0; j < 8; ++j) { const int c = (lane + 64 * j) * 4; const f32x4 gg = *(const f32x4*)(g + c), bb = *(const f32x4*)(b + c);
        const f32x4 y = v[j] * rstd * gg + bb;
        if (hb) { u32x2 w; w.x = cvt_pk_bf16(y[0], y[1]); w.y = cvt_pk_bf16(y[2], y[3]); *(u32x2*)(hb + c) = w; }
        if (fo) *(f32x4*)(fo + c) = y; }
}
#define LN_ROWS(r0, rend, step, ZROW, HBROW, FOROW) do { int r_ = (r0); if (r_ < (rend)) { f32x4 va_[8], vb_[8]; ln_load(va_, ZROW(r_), lane);      \
        for (;;) { const int r1_ = r_ + (step); if (r1_ < (rend)) ln_load(vb_, ZROW(r1_), lane); ln_apply(va_, lg_, lb_, HBROW(r_), FOROW(r_), lane); if (r1_ >= (rend)) break; \
                   const int r2_ = r1_ + (step); if (r2_ < (rend)) ln_load(va_, ZROW(r2_), lane); ln_apply(vb_, lg_, lb_, HBROW(r1_), FOROW(r1_), lane); if (r2_ >= (rend)) break; r_ = r2_; } } } while (0)

__device__ __forceinline__ void conv_silu8(const bf16_t* __restrict__ PROJ, const float* __restrict__ cw, const float* __restrict__ cb, int row, int ch, float (&y)[8]) {
    const f32x4 b0 = *(const f32x4*)(cb + ch), b1 = *(const f32x4*)(cb + ch + 4);
    float a[8] = {b0[0], b0[1], b0[2], b0[3], b1[0], b1[1], b1[2], b1[3]};
#pragma unroll
    for (int k = 0; k < 4; ++k) { const int rr = row - 3 + k;
        if (rr >= 0) { const u32x4 x = *(const u32x4*)(PROJ + (size_t)rr * PW + ch);
            const f32x4 w0 = *(const f32x4*)(cw + k * 1024 + ch), w1 = *(const f32x4*)(cw + k * 1024 + ch + 4);
            a[0] += w0[0] * bflo(x.x); a[1] += w0[1] * bfhi(x.x); a[2] += w0[2] * bflo(x.y); a[3] += w0[3] * bfhi(x.y);
            a[4] += w1[0] * bflo(x.z); a[5] += w1[1] * bfhi(x.z); a[6] += w1[2] * bflo(x.w); a[7] += w1[3] * bfhi(x.w); } }
#pragma unroll
    for (int i = 0; i < 8; ++i) y[i] = a[i] * sigmoidf(a[i]);
}

__device__ __forceinline__ int tsw(int row, int t) { return ((((t >> 1) + 4 * ((row >> 3) & 7)) & 31) << 1) | (t & 1); }

__device__ __forceinline__ void mlstm_local_unit(const Params& P, int l, int h, int n, char* lds) {
    int tid_ = threadIdx.x; asm volatile("" : "+v"(tid_));
    const int tid = tid_, wid = __builtin_amdgcn_readfirstlane(tid >> 6), lane = tid & 63, r32 = lane & 31, hi = lane >> 5;
    const bf16_t* PROJ = (const bf16_t*)(P.ws + WS_PROJ); const float* GATES = (const float*)(P.ws + WS_GATES);
    float* GM = (float*)(P.ws + WS_GM); float* NLOC = (float*)(P.ws + WS_NLOC); bf16_t* CT = (bf16_t*)(P.ws + WS_CT);
    const float* cw = P.in[3] + l * 4096; const float* cb = P.in[4] + l * 1024;
    bf16_t* KT = (bf16_t*)lds; bf16_t* VT = (bf16_t*)(lds + 18432); float* wl = (float*)(lds + 55296);
    const int t0 = n * 64;
    u32x4 kx[2][4], vx[4];
#pragma unroll
    for (int i = 0; i < 2; ++i) { const int idx = tid + 512 * i, t = idx >> 4, c = idx & 15;
#pragma unroll
        for (int k = 0; k < 4; ++k) { const int rr = t0 + t - 3 + k; kx[i][k] = (u32x4){0u, 0u, 0u, 0u};
            if (rr >= 0) kx[i][k] = *(const u32x4*)(PROJ + (size_t)rr * PW + C_MK + h * 128 + c * 8); } }
#pragma unroll
    for (int i = 0; i < 4; ++i) { const int idx = tid + 512 * i, t = idx >> 5, c = idx & 31; vx[i] = *(const u32x4*)(PROJ + (size_t)(t0 + t) * PW + C_MV + h * 256 + c * 8); }
    if (wid == 0) {
        const int row = t0 + lane;
        const float li = GATES[(size_t)row * 16 + h] + P.in[5][l * 4 + h];
        const float lf = logsigmoid(GATES[(size_t)row * 16 + 4 + h] + P.in[6][l * 4 + h]);
        const float b = wave_scan_add(lf, lane);
        const float g = __shfl(b, 63);
        const float a = g - b + li;
        const float ml = wave_max(a);
        wl[lane] = __expf(a - ml);
        if (lane == 0) { GM[(h * NCH + n) * 2] = g; GM[(h * NCH + n) * 2 + 1] = ml; }
    }
    __syncthreads();
#pragma unroll
    for (int i = 0; i < 2; ++i) { const int idx = tid + 512 * i, t = idx >> 4, c = idx & 15; const int ch = C_MK + h * 128 + c * 8;
        const f32x4 b0 = *(const f32x4*)(cb + ch), b1 = *(const f32x4*)(cb + ch + 4);
        float a[8] = {b0[0], b0[1], b0[2], b0[3], b1[0], b1[1], b1[2], b1[3]};
#pragma unroll
        for (int k = 0; k < 4; ++k) { const u32x4 x = kx[i][k];
            const f32x4 w0 = *(const f32x4*)(cw + k * 1024 + ch), w1 = *(const f32x4*)(cw + k * 1024 + ch + 4);
            a[0] += w0[0] * bflo(x.x); a[1] += w0[1] * bfhi(x.x); a[2] += w0[2] * bflo(x.y); a[3] += w0[3] * bfhi(x.y);
            a[4] += w1[0] * bflo(x.z); a[5] += w1[1] * bfhi(x.z); a[6] += w1[2] * bflo(x.w); a[7] += w1[3] * bfhi(x.w); }
        const float w = wl[t];
#pragma unroll
        for (int j = 0; j < 8; ++j) KT[(c * 8 + j) * 72 + tsw(c * 8, t)] = (bf16_t)(cvt_pk_bf16(a[j] * sigmoidf(a[j]) * w, 0.f) & 0xffffu); }
#pragma unroll
    for (int i = 0; i < 4; ++i) { const int idx = tid + 512 * i, t = idx >> 5, c = idx & 31;
        const u32x4 x = vx[i];
        bf16_t* vp = VT + (c * 8) * 72 + tsw(c * 8, t);
        vp[0] = (bf16_t)(x.x & 0xffffu); vp[72] = (bf16_t)(x.x >> 16); vp[144] = (bf16_t)(x.y & 0xffffu); vp[216] = (bf16_t)(x.y >> 16);
        vp[288] = (bf16_t)(x.z & 0xffffu); vp[360] = (bf16_t)(x.z >> 16); vp[432] = (bf16_t)(x.w & 0xffffu); vp[504] = (bf16_t)(x.w >> 16); }
    __syncthreads();
    const int db = wid & 3, eb0 = (wid >> 2) * 4;
    f32x16 acc[4] = {};
#pragma unroll
    for (int ks = 0; ks < 4; ++ks) { const bf16x8 A = *(const bf16x8*)(KT + (32 * db + r32) * 72 + tsw(32 * db + r32, 16 * ks + 8 * hi));
#pragma unroll
        for (int j = 0; j < 4; ++j) { const bf16x8 B = *(const bf16x8*)(VT + (32 * (eb0 + j) + r32) * 72 + tsw(32 * (eb0 + j) + r32, 16 * ks + 8 * hi));
            acc[j] = __builtin_amdgcn_mfma_f32_32x32x16_bf16(A, B, acc[j], 0, 0, 0); } }
    if (tid < 128) { float s = 0.f;
#pragma unroll
        for (int q = 0; q < 8; ++q) { const u32x4 x = *(const u32x4*)(KT + tid * 72 + 8 * q);
            s += (bflo(x.x) + bfhi(x.x)) + (bflo(x.y) + bfhi(x.y)) + (bflo(x.z) + bfhi(x.z)) + (bflo(x.w) + bfhi(x.w)); }
        NLOC[(size_t)(h * NCH + n) * 128 + tid] = s; }
    bf16_t* ct = CT + (size_t)(h * NCH + n) * 32768;
#pragma unroll
    for (int j = 0; j < 4; ++j) { const int e = 32 * (eb0 + j) + r32;
#pragma unroll
        for (int q = 0; q < 4; ++q) { u32x2 w; w.x = cvt_pk_bf16(acc[j][4 * q], acc[j][4 * q + 1]); w.y = cvt_pk_bf16(acc[j][4 * q + 2], acc[j][4 * q + 3]);
            *(u32x2*)(ct + e * 128 + 32 * db + 8 * q + 4 * hi) = w; } }
    __syncthreads();
}

__device__ __forceinline__ void fox_cumsum(const Params& P, int l, int head, char* lds) {
    int tidl_ = threadIdx.x; asm volatile("" : "+v"(tidl_));
    const int tid = tidl_, wid = tid >> 6, lane = tid & 63;
    const float* GATES = (const float*)(P.ws + WS_GATES); float* CF = (float*)(P.ws + WS_CF) + (size_t)head * CFP;
    const float fb = P.in[8][l * 8 + head];
    double* tot = (double*)(lds + 4096);
    const int base = 33 * tid;
    float lf[33];
#pragma unroll
    for (int k = 0; k < 33; ++k) { const int t = base + k; lf[k] = t < LTOK ? GATES[(size_t)t * 16 + 8 + head] : 0.f; }
    double s = 0.0;
#pragma unroll
    for (int k = 0; k < 33; ++k) { const int t = base + k; lf[k] = t < LTOK ? logsigmoid(lf[k] + fb) : 0.f; s += (double)lf[k]; }
    double inc = s;
#pragma unroll
    for (int o = 1; o < 64; o <<= 1) { const double y = __shfl_up(inc, o); if (lane >= o) inc += y; }
    if (lane == 63) tot[wid] = inc;
    __syncthreads();
    double run = inc - s;
    for (int w = 0; w < wid; ++w) run += tot[w];
#pragma unroll
    for (int k = 0; k < 33; ++k) { run += (double)lf[k]; CF[base + k] = (float)run; }
    __syncthreads();
}

__device__ __forceinline__ void fox_norms(const Params& P, int l, int gw, int NGW, int lane) {
    const bf16_t* PROJ = (const bf16_t*)(P.ws + WS_PROJ); unsigned* nrm = (unsigned*)(P.ws + WS_CTL) + 512 + l * 1024;
    float mq = 0.f, mk = 0.f;
    for (int base = gw * 8; base < LTOK; base += NGW * 8) {
        float dmin = 0.f;
        for (int i = 0; i < 8; ++i) { const int r = base + i; if (r >= LTOK) break;
            const u32x4* q = (const u32x4*)(PROJ + (size_t)r * PW + C_FQ + lane * 16); const u32x4* k = (const u32x4*)(PROJ + (size_t)r * PW + C_FK + lane * 16);
            float sq = 0.f, sk = 0.f, qk = 0.f;
#pragma unroll
            for (int j = 0; j < 2; ++j) { const u32x4 a = q[j], b = k[j];
                sq += bflo(a.x) * bflo(a.x) + bfhi(a.x) * bfhi(a.x) + bflo(a.y) * bflo(a.y) + bfhi(a.y) * bfhi(a.y) + bflo(a.z) * bflo(a.z) + bfhi(a.z) * bfhi(a.z) + bflo(a.w) * bflo(a.w) + bfhi(a.w) * bfhi(a.w);
                sk += bflo(b.x) * bflo(b.x) + bfhi(b.x) * bfhi(b.x) + bflo(b.y) * bflo(b.y) + bfhi(b.y) * bfhi(b.y) + bflo(b.z) * bflo(b.z) + bfhi(b.z) * bfhi(b.z) + bflo(b.w) * bflo(b.w) + bfhi(b.w) * bfhi(b.w);
                qk += bflo(a.x) * bflo(b.x) + bfhi(a.x) * bfhi(b.x) + bflo(a.y) * bflo(b.y) + bfhi(a.y) * bfhi(b.y) + bflo(a.z) * bflo(b.z) + bfhi(a.z) * bfhi(b.z) + bflo(a.w) * bflo(b.w) + bfhi(a.w) * bfhi(b.w); }
            sq += __shfl_xor(sq, 1); sq += __shfl_xor(sq, 2); sq += __shfl_xor(sq, 4); sk += __shfl_xor(sk, 1); sk += __shfl_xor(sk, 2); sk += __shfl_xor(sk, 4);
            qk += __shfl_xor(qk, 1); qk += __shfl_xor(qk, 2); qk += __shfl_xor(qk, 4);
            mq = fmaxf(mq, sq); mk = fmaxf(mk, sk); dmin = fminf(dmin, qk * fox::SCALE - 1e-3f * fabsf(qk * fox::SCALE)); }
        if ((lane & 7) == 0) { const int bits = (int)__float_as_uint(dmin); atomicMin((int*)nrm + 128 + (lane >> 3) * 80 + (base >> 8), bits ^ ((bits >> 31) & 0x7fffffff)); }
    }
    if ((lane & 7) == 0) { atomicMax(nrm + (lane >> 3) * 2, __float_as_uint(mq)); atomicMax(nrm + (lane >> 3) * 2 + 1, __float_as_uint(mk)); }
}

__device__ __forceinline__ void mlstm_scan_item(const Params& P, int item) {
    int tid_ = threadIdx.x; asm volatile("" : "+v"(tid_));
    const int tid = tid_, h = item >> 3, sl = item & 7;
    bf16_t* p = (bf16_t*)(P.ws + WS_CT) + (size_t)h * NCH * 32768 + sl * 4096 + tid * 8;
    int zv = 0; asm volatile("" : "+v"(zv));
    const float* GM = (const float*)(P.ws + WS_GM) + (size_t)h * NCH * 2 + zv;
    float* MPREV = (float*)(P.ws + WS_MPREV) + h * NCH;
    const bool hasn = (sl == 0) && tid < 128, wm = (sl == 0) && tid == 0;
    float* np = (float*)(P.ws + WS_NLOC) + (size_t)h * NCH * 128 + tid;
    float c0 = 0.f, c1 = 0.f, c2 = 0.f, c3 = 0.f, c4 = 0.f, c5 = 0.f, c6 = 0.f, c7 = 0.f, ncar = 0.f, m = 0.f;
#define PACK_CARRY() (u32x4){cvt_pk_bf16(c0, c1), cvt_pk_bf16(c2, c3), cvt_pk_bf16(c4, c5), cvt_pk_bf16(c6, c7)}
    for (int n0 = 0; n0 < 256; n0 += 16) {
        u32x4 cl[16]; float nl[16];
#pragma unroll
        for (int j = 0; j < 16; ++j) cl[j] = *(const u32x4*)(p + (size_t)(n0 + j) * 32768);
        if (hasn) {
#pragma unroll
            for (int j = 0; j < 16; ++j) nl[j] = np[(size_t)(n0 + j) * 128];
        } else {
#pragma unroll
            for (int j = 0; j < 16; ++j) nl[j] = 0.f;
        }
#pragma unroll
        for (int j = 0; j < 16; ++j) { const int n = n0 + j; const float g = GM[n * 2], ml = GM[n * 2 + 1];
            *(u32x4*)(p + (size_t)n * 32768) = PACK_CARRY();
            if (hasn) np[(size_t)n * 128] = ncar;
            if (wm) MPREV[n] = m;
            const float mn = fmaxf(g + m, ml), sp = __expf(g + m - mn), sq = __expf(ml - mn);
            c0 = sp * c0 + sq * bflo(cl[j].x); c1 = sp * c1 + sq * bfhi(cl[j].x); c2 = sp * c2 + sq * bflo(cl[j].y); c3 = sp * c3 + sq * bfhi(cl[j].y);
            c4 = sp * c4 + sq * bflo(cl[j].z); c5 = sp * c5 + sq * bfhi(cl[j].z); c6 = sp * c6 + sq * bflo(cl[j].w); c7 = sp * c7 + sq * bfhi(cl[j].w);
            ncar = sp * ncar + sq * nl[j]; m = mn; }
    }
    *(u32x4*)(p + (size_t)256 * 32768) = PACK_CARRY();
    if (hasn) np[(size_t)256 * 128] = ncar;
    if (wm) MPREV[256] = m;
#undef PACK_CARRY
}

__device__ __forceinline__ void mlstm_out_unit(const Params& P, int l, int h, int n, char* lds) {
    int tid_ = threadIdx.x; asm volatile("" : "+v"(tid_));
    const int tid = tid_, wid = __builtin_amdgcn_readfirstlane(tid >> 6), lane = tid & 63, r32 = lane & 31, hi = lane >> 5;
    const bf16_t* PROJ = (const bf16_t*)(P.ws + WS_PROJ); const float* GATES = (const float*)(P.ws + WS_GATES);
    const float* NPREV = (const float*)(P.ws + WS_NLOC) + (size_t)(h * NCH + n) * 128; const float* MPREV = (const float*)(P.ws + WS_MPREV);
    const bf16_t* ct = (const bf16_t*)(P.ws + WS_CT) + (size_t)(h * NCH + n) * 32768; bf16_t* MIX = (bf16_t*)(P.ws + WS_MIX);
    const float* cw = P.in[3] + l * 4096; const float* cb = P.in[4] + l * 1024; const float* mnorm = P.in[7] + l * 1024 + h * 256;
    bf16_t* Ql = (bf16_t*)lds; bf16_t* Kl = (bf16_t*)(lds + 17408); bf16_t* VT = (bf16_t*)(lds + 34816); bf16_t* Wl = (bf16_t*)(lds + 71680);
    float* tab = (float*)(lds + 80896); float* ul = tab, * vl = tab + 64, * sil = tab + 128, * eml = tab + 192, * rden = tab + 256, * npv = tab + 320;
    float* Hb = (float*)lds;
    const int t0 = n * 64;
    if (wid == 0) {
        const int row = t0 + lane;
        const float li = GATES[(size_t)row * 16 + h] + P.in[5][l * 4 + h];
        const float lf = logsigmoid(GATES[(size_t)row * 16 + 4 + h] + P.in[6][l * 4 + h]);
        const float b = wave_scan_add(lf, lane);
        const float v = li - b;
        const float pm = wave_scan_max(v, lane);
        int zv = 0; asm volatile("" : "+v"(zv));
        const float mp = MPREV[h * NCH + n + zv];
        const float mx = fmaxf(mp, pm);
        ul[lane] = -mx; vl[lane] = v; sil[lane] = __expf(mp - mx); eml[lane] = __expf(-(b + mx));
    } else if (wid <= 2) { const int d = tid - 64; npv[d] = NPREV[d]; }
#pragma unroll
    for (int i = 0; i < 4; ++i) { const int idx = tid + 512 * i, which = idx >> 10, t = (idx >> 4) & 63, c = idx & 15; float y[8];
        conv_silu8(PROJ, cw, cb, t0 + t, which * 512 + h * 128 + c * 8, y);
        const float sc = which ? 1.f : 0.08838834764831845f;
        u32x4 w; w.x = cvt_pk_bf16(y[0] * sc, y[1] * sc); w.y = cvt_pk_bf16(y[2] * sc, y[3] * sc); w.z = cvt_pk_bf16(y[4] * sc, y[5] * sc); w.w = cvt_pk_bf16(y[6] * sc, y[7] * sc);
        *(u32x4*)((which ? Kl : Ql) + t * 136 + c * 8) = w; }
#pragma unroll
    for (int i = 0; i < 4; ++i) { const int idx = tid + 512 * i, t = idx >> 5, c = idx & 31;
        const u32x4 x = *(const u32x4*)(PROJ + (size_t)(t0 + t) * PW + C_MV + h * 256 + c * 8);
        bf16_t* vp = VT + (c * 8) * 72 + tsw(c * 8, t);
        vp[0] = (bf16_t)(x.x & 0xffffu); vp[72] = (bf16_t)(x.x >> 16); vp[144] = (bf16_t)(x.y & 0xffffu); vp[216] = (bf16_t)(x.y >> 16);
        vp[288] = (bf16_t)(x.z & 0xffffu); vp[360] = (bf16_t)(x.z >> 16); vp[432] = (bf16_t)(x.w & 0xffffu); vp[504] = (bf16_t)(x.w >> 16); }
    bf16x8 cfr[8];
#pragma unroll
    for (int ks = 0; ks < 8; ++ks) cfr[ks] = *(const bf16x8*)(ct + (size_t)(32 * wid + r32) * 128 + 16 * ks + 8 * hi);
    __syncthreads();
    if (wid < 4) {
        const int ti = wid >> 1, si = wid & 1;
        f32x16 acc = {};
        if (si <= ti) {
#pragma unroll
            for (int ks = 0; ks < 8; ++ks) { const bf16x8 A = *(const bf16x8*)(Ql + (32 * ti + r32) * 136 + 16 * ks + 8 * hi);
                const bf16x8 B = *(const bf16x8*)(Kl + (32 * si + r32) * 136 + 16 * ks + 8 * hi);
                acc = __builtin_amdgcn_mfma_f32_32x32x16_bf16(A, B, acc, 0, 0, 0); }
        }
        const int s = 32 * si + r32; const float vs = vl[s];
#pragma unroll
        for (int r = 0; r < 16; ++r) { const int t = 32 * ti + fox::crow(r, hi);
            const float wv = (s <= t) ? acc[r] * __expf(ul[t] + vs) : 0.f;
            Wl[t * 72 + s] = (bf16_t)(cvt_pk_bf16(wv, 0.f) & 0xffffu); }
    }
    __syncthreads();
    {
        const int t = tid >> 3, p = tid & 7;
        const u32x4 x = *(const u32x4*)(Wl + t * 72 + 8 * p);
        float ws_ = (bflo(x.x) + bfhi(x.x)) + (bflo(x.y) + bfhi(x.y)) + (bflo(x.z) + bfhi(x.z)) + (bflo(x.w) + bfhi(x.w));
        const u32x4 q0 = *(const u32x4*)(Ql + t * 136 + 16 * p), q1 = *(const u32x4*)(Ql + t * 136 + 16 * p + 8);
        const float* nn = npv + 16 * p;
        float qn = bflo(q0.x) * nn[0] + bfhi(q0.x) * nn[1] + bflo(q0.y) * nn[2] + bfhi(q0.y) * nn[3] + bflo(q0.z) * nn[4] + bfhi(q0.z) * nn[5] + bflo(q0.w) * nn[6] + bfhi(q0.w) * nn[7]
                 + bflo(q1.x) * nn[8] + bfhi(q1.x) * nn[9] + bflo(q1.y) * nn[10] + bfhi(q1.y) * nn[11] + bflo(q1.z) * nn[12] + bfhi(q1.z) * nn[13] + bflo(q1.w) * nn[14] + bfhi(q1.w) * nn[15];
        float tot = ws_ + sil[t] * qn;
        tot += __shfl_xor(tot, 1); tot += __shfl_xor(tot, 2); tot += __shfl_xor(tot, 4);
        if (p == 0) rden[t] = 1.f / fmaxf(fabsf(tot), eml[t]);
    }
    f32x16 a1[2] = {}, a2[2] = {};
#pragma unroll
    for (int ks = 0; ks < 4; ++ks) { const bf16x8 B = *(const bf16x8*)(VT + (32 * wid + r32) * 72 + tsw(32 * wid + r32, 16 * ks + 8 * hi));
#pragma unroll
        for (int ti = 0; ti < 2; ++ti) { const bf16x8 A = *(const bf16x8*)(Wl + (32 * ti + r32) * 72 + 16 * ks + 8 * hi);
            a1[ti] = __builtin_amdgcn_mfma_f32_32x32x16_bf16(A, B, a1[ti], 0, 0, 0); } }
#pragma unroll
    for (int ks = 0; ks < 8; ++ks) {
#pragma unroll
        for (int ti = 0; ti < 2; ++ti) { const bf16x8 A = *(const bf16x8*)(Ql + (32 * ti + r32) * 136 + 16 * ks + 8 * hi);
            a2[ti] = __builtin_amdgcn_mfma_f32_32x32x16_bf16(A, cfr[ks], a2[ti], 0, 0, 0); } }
    __syncthreads();
#pragma unroll
    for (int ti = 0; ti < 2; ++ti)
#pragma unroll
        for (int r = 0; r < 16; ++r) { const int t = 32 * ti + fox::crow(r, hi);
            Hb[t * 260 + 32 * wid + r32] = (a1[ti][r] + sil[t] * a2[ti][r]) * rden[t]; }
    __syncthreads();
    {
        const int t = tid >> 3, p = tid & 7; f32x4 hv[8]; float ss = 0.f;
#pragma unroll
        for (int j = 0; j < 8; ++j) { hv[j] = *(const f32x4*)(Hb + t * 260 + 32 * j + 4 * p); ss += (hv[j][0] * hv[j][0] + hv[j][1] * hv[j][1]) + (hv[j][2] * hv[j][2] + hv[j][3] * hv[j][3]); }
        ss += __shfl_xor(ss, 1); ss += __shfl_xor(ss, 2); ss += __shfl_xor(ss, 4);
        const float rs = rsqrtf(ss * (1.f / 256.f) + RMS_EPS);
        const size_t row = (size_t)(t0 + t);
#pragma unroll
        for (int j = 0; j < 8; ++j) { const int e = 32 * j + 4 * p; const f32x4 gn = *(const f32x4*)(mnorm + e);
            const u32x2 mo = *(const u32x2*)(PROJ + row * PW + C_MO + h * 256 + e);
            const float o0 = hv[j][0] * rs * gn[0] * sigmoidf(bflo(mo.x)), o1 = hv[j][1] * rs * gn[1] * sigmoidf(bfhi(mo.x));
            const float o2 = hv[j][2] * rs * gn[2] * sigmoidf(bflo(mo.y)), o3 = hv[j][3] * rs * gn[3] * sigmoidf(bfhi(mo.y));
            u32x2 w; w.x = cvt_pk_bf16(o0, o1); w.y = cvt_pk_bf16(o2, o3);
            *(u32x2*)(MIX + row * DM + h * 256 + e) = w; }
    }
    __syncthreads();
}

#define XB_TMO      128
#define XB_XCNT(j)  (256  + 64 * (j))
#define XB_XSUB(j)  (1280 + 64 * (j))
#define XB_XGEN(j)  (2304 + 64 * (j))
#define XB_TOP      3328
#define XB_TOPGEN   3392
#define XCD_BAR_WORDS 3456
#define XB_SPIN_CAP (1u << 18)

__device__ __forceinline__ unsigned xb_ld(unsigned* p)              { return __hip_atomic_load(p, __ATOMIC_RELAXED, __HIP_MEMORY_SCOPE_AGENT); }
__device__ __forceinline__ unsigned xb_add(unsigned* p, unsigned v) { return __hip_atomic_fetch_add(p, v, __ATOMIC_RELAXED, __HIP_MEMORY_SCOPE_AGENT); }
__device__ __forceinline__ unsigned xb_xcc_id() { return (unsigned)__builtin_amdgcn_s_getreg((3 << 11) | 20) & 0xFu; }
#define XB_SPIN(cond, bar) do { unsigned _sp = 0; while (cond) { __builtin_amdgcn_s_sleep(1); \
    if ((++_sp & 255u) == 0u) { if (xb_ld(&(bar)[XB_TMO])) break; if (_sp > XB_SPIN_CAP) { atomicAdd(&(bar)[XB_TMO], 1u); break; } } } } while (0)

struct XcdBarrier {
    unsigned* bar; unsigned x;
    volatile LAS unsigned* st;
};

__device__ __forceinline__ XcdBarrier xcd_barrier_post(unsigned* bar, volatile LAS unsigned* st) {
    XcdBarrier b; b.bar = bar; b.x = xb_xcc_id(); b.st = st;
    if (threadIdx.x == 0) (void)xb_add(&bar[XB_XCNT(b.x)], 1u);
    return b;
}
__device__ __forceinline__ void xcd_barrier_complete(unsigned* bar, unsigned x, unsigned& nloc, unsigned& nx) {
    const unsigned G = gridDim.x * gridDim.y * gridDim.z;
    unsigned sum, cnt, mine, sp = 0u;
    for (;;) {
        sum = 0u; cnt = 0u; mine = 0u;
#pragma unroll
        for (unsigned j = 0; j < 16; ++j) { const unsigned c = xb_ld(&bar[XB_XCNT(j)]); sum += c; cnt += (c > 0u) ? 1u : 0u; mine = (j == x) ? c : mine; }
        if (sum == G) break;
        __builtin_amdgcn_s_sleep(1);
        if ((++sp & 255u) == 0u) { if (xb_ld(&bar[XB_TMO])) break; if (sp > XB_SPIN_CAP) { atomicAdd(&bar[XB_TMO], 1u); break; } }
    }
    nloc = mine > 0u ? mine : 1u; nx = cnt > 0u ? cnt : 1u;
}

__device__ __forceinline__ void xcd_barrier(const XcdBarrier& b) {
    asm volatile("s_waitcnt vmcnt(0)" ::: "memory");
    __syncthreads();
    if (threadIdx.x == 0) {
        unsigned* bar = b.bar;
        __builtin_amdgcn_s_waitcnt(0);
        unsigned nloc = b.st[0], nx = b.st[1];
        if (nloc == 0u) { xcd_barrier_complete(bar, b.x, nloc, nx); b.st[0] = nloc; b.st[1] = nx; }
        const unsigned old = xb_add(&bar[XB_XSUB(b.x)], 1u);
        const unsigned gen = old / nloc;
        if (old + 1u == (gen + 1u) * nloc) {
            __builtin_amdgcn_fence(__ATOMIC_RELEASE, "agent");
            asm volatile("s_waitcnt vmcnt(0)" ::: "memory");
            const unsigned og = xb_add(&bar[XB_TOP], 1u);
            const unsigned tg = og / nx;
            if (og + 1u == (tg + 1u) * nx) xb_add(&bar[XB_TOPGEN], 1u);
            else XB_SPIN(xb_ld(&bar[XB_TOPGEN]) == tg, bar);
            __builtin_amdgcn_fence(__ATOMIC_ACQUIRE, "agent");
            xb_add(&bar[XB_XGEN(b.x)], 1u);
            asm volatile("s_waitcnt vmcnt(0)" ::: "memory");
        } else {
            XB_SPIN(xb_ld(&bar[XB_XGEN(b.x)]) == gen, bar);
            __builtin_amdgcn_fence(__ATOMIC_ACQUIRE, "agent");
            asm volatile("s_waitcnt vmcnt(0)" ::: "memory");
        }
    }
    __syncthreads();
}

constexpr int CW_BAR = 4096;
#ifndef TEST_SP
#define TEST_EN(k) true
#else
#define TEST_EN(k) ((k) == TEST_SP)
#endif
#ifndef PROBE_DUP
#define PROBE_DUP -1
#endif
constexpr int NPHASE = 19;
#define PH_IN(k) (P0.ph_lo <= (k) && (k) < P0.ph_hi)
#define PH_SYNC(k) do { if (PH_IN(k) && PH_IN((k) + 1)) { if (P0.ph_lo < 0) { __threadfence(); cg::this_grid().sync(); }   { \
        XcdBarrier bar_; bar_.bar = (unsigned*)(load_params().ws + WS_CTL) + CW_BAR; bar_.x = xb_xcc_id(); bar_.st = (volatile LAS unsigned*)((LAS char*)lds + LDS_MISC + 64); xcd_barrier(bar_); if (PROBE_DUP == 10) xcd_barrier(bar_); } } } while (0)

#define PH_SYNC_ALWAYS() do { XcdBarrier bar_; bar_.bar = (unsigned*)(load_params().ws + WS_CTL) + CW_BAR; bar_.x = xb_xcc_id(); bar_.st = (volatile LAS unsigned*)((LAS char*)lds + LDS_MISC + 64); xcd_barrier(bar_); } while (0)
__device__ __forceinline__ Params load_params() {
    typedef const unsigned long long __attribute__((address_space(4)))* kptr_t;
    kptr_t p = (kptr_t)__builtin_amdgcn_kernarg_segment_ptr();
    asm volatile("" : "+s"(p));
    Params r;
#pragma unroll
    for (int i = 0; i < 17; ++i) r.in[i] = (const float*)p[i];
    r.out = (float*)p[17]; r.ws = (unsigned char*)p[18]; r.ph_lo = 0; r.ph_hi = 0;
    return r;
}
#define PH_BEGIN const Params P = load_params(); unsigned char* ws = P.ws;
template <int L, int K>
__device__ __forceinline__ void phase_body(char* lds, int rep_) {
    int tidl_ = threadIdx.x; asm volatile("" : "+v"(tidl_));
    const int tid = tidl_, lane = tid & 63, wid = __builtin_amdgcn_readfirstlane(tid >> 6);
    const int G = gridDim.x, bx = blockIdx.x;
    const int gw = bx * 8 + wid, NGW = G * 8;
    PG8_LAS unsigned char* glds = (PG8_LAS unsigned char*)lds;
    (void)lane; (void)gw; (void)NGW; (void)glds; (void)rep_;
    if constexpr (K == 0) { PH_BEGIN
        const bf16_t* HB = (const bf16_t*)(ws + WS_HB); const bf16_t* WinT = (const bf16_t*)(ws + WS_WIN);
        skinny_gemm<2>(WinT + (size_t)PW * DM, DM, HB, DM, SEQ / 16, lds, SkGates{(float*)(ws + WS_GATES)});
        skinny_gemm<8>(WinT + (size_t)PW * DM, DM, HB + (size_t)SEQ * DM, DM, 1, lds, SkGates{(float*)(ws + WS_GATES) + (size_t)SEQ * 16});
        skinny_gemm<4>(HB, DM, WinT, DM, PW / 16, lds, SkProj{(bf16_t*)(ws + WS_PROJ)});
        pg8::Gemm g{HB + (size_t)NMETA * DM, WinT, SEQ, PW, DM}; pg8::StaticOrder S; S.init(SEQ, PW, G, bx);
        EpiProj E{(bf16_t*)(ws + WS_PROJ)};
        pg8::gemm_phase<EpiProj, pg8::StaticOrder, true, true>(glds, g, S, E);
    }
    if constexpr (K == 1) {
#define DEP_() ((unsigned*)(load_params().ws + WS_CTL) + 128 + L * 64 + rp_ * 32)
#ifdef PROBE_MIX
        int nrp_ = 2; asm volatile("" : "+s"(nrp_));
#else
        const int nrp_ = 1;
#endif
        for (int rp_ = 0; rp_ < nrp_; ++rp_) {
        const int xcc = (int)(xb_xcc_id() & 7u); const bool heavy = xcc >= 7;
        { const Params P = load_params(); fox_norms(P, L, gw, NGW, lane); if (bx < 8) fox_cumsum(P, L, bx, lds); }
        signal_done(DEP_() + 5);
        if (((bx >> 3) & 7) == 0) {
            const Params P = load_params();
            convert_weights(P, L, 2, lds, ((bx >> 6) * 8 + (bx & 7)) * 8 + wid, 32 * 8, wid, lane);
            __syncthreads();
        }
        int nstage_ = 2; asm volatile("" : "+s"(nstage_));
        for (int stage = 0; stage < nstage_; ++stage) {
            if ((stage == 0) == heavy) {
                wait_count(DEP_() + 5, (unsigned)G);
                const Params P = load_params(); unsigned char* ws = P.ws;
                unsigned* qh = (unsigned*)(ws + WS_CTL) + 16 + L * 16 + rp_ * 8; const unsigned* nrm = (unsigned*)(ws + WS_CTL) + 512 + L * 1024;
                bf16_t* PROJ = (bf16_t*)(ws + WS_PROJ); bf16_t* MIX = (bf16_t*)(ws + WS_MIX);
                const float* CF = (const float*)(ws + WS_CF); const float* fnorm = P.in[9] + L * 1024;
                for (;;) {
                    volatile int* slot = (volatile int*)(lds + LDS_MISC);
                    if (tid == 0) *slot = fox::fox_take(qh, xcc);
                    __syncthreads();
                    const int ci = __builtin_amdgcn_readfirstlane(*slot);
                    __syncthreads();
                    if (ci < 0) break;
                    fox::Seam S;
                    fox::BlockRef cur, nxt; fox::fox_ref(ci, cur, PROJ, MIX); cur.jlo = fox::fox_jlo(CF, nrm, cur.head, cur.P0);
                    fox::fox_prime(cur, lds, S);
                    for (;;) {
                        const bool more = fox::fox_block(cur, nxt, qh, nrm, PROJ, MIX, lds, S, CF, fnorm);
                        if (!more) break;
                        cur = nxt;
                    }
                }
            }
            if (stage == 0) {
                unsigned nloc_ = 0;
                for (;;) { const int u = fetch_item(DEP_() + 0, lds); if (u >= 1024) break; { const Params P = load_params(); mlstm_local_unit(P, L, u & 3, u >> 2, lds); } ++nloc_; }
                if (nloc_) signal_done(DEP_() + 1, nloc_);
                for (;;) { const int s = fetch_item(DEP_() + 2, lds); if (s >= 32) break; wait_count(DEP_() + 1, 1024u); { const Params P = load_params(); mlstm_scan_item(P, s); } signal_done(DEP_() + 3); }
            }
        }
        wait_count(DEP_() + 3, 32u);
        for (;;) { const int u = fetch_item(DEP_() + 4, lds); if (u >= 4 * NCH) break; const Params P = load_params(); mlstm_out_unit(P, L, u & 3, u >> 2, lds); }
        }
#undef DEP_
    }
    if constexpr (K == 4) { PH_BEGIN
        const bf16_t* MIX = (const bf16_t*)(ws + WS_MIX); const bf16_t* WoutT = (const bf16_t*)(ws + WS_WOUT); const bf16_t* HB = (const bf16_t*)(ws + WS_HB);
        skinny_gemm<8>(MIX, DM, WoutT, DM, DM / 16, lds, SkRes{HB, (float*)(ws + WS_Z1)});
        pg8::Gemm g{MIX + (size_t)NMETA * DM, WoutT, SEQ, DM, DM}; pg8::StaticOrder S; S.init(SEQ, DM, G, bx);
        EpiRes<0> E{HB, (float*)(ws + WS_Z1)};
        pg8::gemm_phase<EpiRes<0>, pg8::StaticOrder, true, true>(glds, g, S, E);
    }
    if constexpr (K == 5) { PH_BEGIN
        const float* g1 = P.in[11] + L * DM; const float* b1 = P.in[12] + L * DM; const float* Z1 = (const float*)(ws + WS_Z1); bf16_t* HB = (bf16_t*)(ws + WS_HB);
        const float* lg_ = g1; const float* lb_ = b1;
#define ZR_(r) (Z1 + (size_t)(r) * DM)
#define HR_(r) (HB + (size_t)(r) * DM)
#define FR_(r) ((float*)nullptr)
        LN_ROWS(gw, LTOK, NGW, ZR_, HR_, FR_);
#undef ZR_
#undef HR_
#undef FR_
    }
    if constexpr (K == 6) { PH_BEGIN
        const bf16_t* HB = (const bf16_t*)(ws + WS_HB); const bf16_t* WupT = (const bf16_t*)(ws + WS_WUP);
        skinny_gemm<4>(HB, DM, WupT, DM, DFF / 16, lds, SkSqRelu{(bf16_t*)(ws + WS_U)});
        pg8::Gemm g{HB + (size_t)NMETA * DM, WupT, SEQ, DFF, DM}; pg8::StaticOrder S; S.init(SEQ, DFF, G, bx);
        EpiSqRelu E{(bf16_t*)(ws + WS_U)};
        pg8::gemm_phase<EpiSqRelu, pg8::StaticOrder, true, true>(glds, g, S, E);
    }
    if constexpr (K == 7) { PH_BEGIN
        const bf16_t* U = (const bf16_t*)(ws + WS_U); const bf16_t* WdownT = (const bf16_t*)(ws + WS_WDOWN); const bf16_t* HB = (const bf16_t*)(ws + WS_HB);
        skinny_gemm<8>(U, DFF, WdownT, DFF, DM / 16, lds, SkRes{HB, (float*)(ws + WS_ZS)});
        pg8::Gemm g{U + (size_t)NMETA * DFF, WdownT, SEQ, DM, DFF}; pg8::StaticOrder S; S.init(SEQ, DM, G, bx);
        EpiRes<1> E{HB, P.out};
        pg8::gemm_phase<EpiRes<1>, pg8::StaticOrder, true, true>(glds, g, S, E);
    }
    if constexpr (K == 8) { PH_BEGIN
        const float* g2 = P.in[15] + L * DM; const float* b2 = P.in[16] + L * DM; const float* ZS = (const float*)(ws + WS_ZS); bf16_t* HB = (bf16_t*)(ws + WS_HB);
        if (L == 0) {
            const float* lg_ = g2; const float* lb_ = b2;
#define ZR_(r) ((r) >= NMETA ? P.out + (size_t)((r) - NMETA) * DM : ZS + (size_t)(r) * DM)
#define HR_(r) (HB + (size_t)(r) * DM)
#define FR_(r) ((float*)nullptr)
            LN_ROWS(gw, LTOK, NGW, ZR_, HR_, FR_);
#undef ZR_
#undef HR_
#undef FR_
            convert_weights(P, 1, 1, lds, gw, NGW, wid, lane);
            zero_pad_rows(P);
        } else {
            const float* lg_ = g2; const float* lb_ = b2;
#define ZR_(r) (P.out + (size_t)((r) - NMETA) * DM)
#define HR_(r) ((bf16_t*)nullptr)
#define FR_(r) (P.out + (size_t)((r) - NMETA) * DM)
            LN_ROWS(gw + NMETA, LTOK, NGW, ZR_, HR_, FR_);
#undef ZR_
#undef HR_
#undef FR_
        }
    }
}
template <int L>
__device__ __forceinline__ void run_layer(const Params& P0, char* lds) {
    constexpr int B0 = 1 + 9 * L;
    if (PH_IN(B0 + 0)) { if (TEST_EN(0)) { phase_body<L, 0>(lds, 0); if (PROBE_DUP == 0) phase_body<L, 0>(lds, 1); } }
    PH_SYNC(B0 + 0);
    if (PH_IN(B0 + 1)) { if (TEST_EN(1)) { phase_body<L, 1>(lds, 0); if (PROBE_DUP == 1) phase_body<L, 1>(lds, 1); } }
    if (PH_IN(B0 + 3)) PH_SYNC_ALWAYS();
    if (PH_IN(B0 + 4)) { if (TEST_EN(4)) { phase_body<L, 4>(lds, 0); if (PROBE_DUP == 4) phase_body<L, 4>(lds, 1); } }
    PH_SYNC(B0 + 4);
    if (PH_IN(B0 + 5)) { if (TEST_EN(5)) { phase_body<L, 5>(lds, 0); if (PROBE_DUP == 5) phase_body<L, 5>(lds, 1); } }
    PH_SYNC(B0 + 5);
    if (PH_IN(B0 + 6)) { if (TEST_EN(6)) { phase_body<L, 6>(lds, 0); if (PROBE_DUP == 6) phase_body<L, 6>(lds, 1); } }
    PH_SYNC(B0 + 6);
    if (PH_IN(B0 + 7)) { if (TEST_EN(7)) { phase_body<L, 7>(lds, 0); if (PROBE_DUP == 7) phase_body<L, 7>(lds, 1); } }
    PH_SYNC(B0 + 7);
    if (PH_IN(B0 + 8)) { if (TEST_EN(8)) { phase_body<L, 8>(lds, 0); if (PROBE_DUP == 8 && L == 0) phase_body<L, 8>(lds, 1); } }
    if (L == 0) PH_SYNC(B0 + 8);
}

__global__ void __launch_bounds__(512) hymba_fwd(Params P0) {
    extern __shared__ __attribute__((aligned(16))) char lds[];
    { volatile LAS unsigned* st = (volatile LAS unsigned*)((LAS char*)lds + LDS_MISC + 64);
      if (threadIdx.x < 2) st[threadIdx.x] = 0u;
      __syncthreads();
      (void)xcd_barrier_post((unsigned*)(load_params().ws + WS_CTL) + CW_BAR, st); }
    if (PH_IN(0)) { if (TEST_EN(9)) { int npro_ = (PROBE_DUP == 9) ? 2 : 1; asm volatile("" : "+s"(npro_)); for (int rp_ = 0; rp_ < npro_; ++rp_) { const Params P = load_params();
        int tidl_ = threadIdx.x; asm volatile("" : "+v"(tidl_));
    const int tid = tidl_, lane = tid & 63, wid = __builtin_amdgcn_readfirstlane(tid >> 6);
        const int gw = blockIdx.x * 8 + wid, NGW = gridDim.x * 8;
        const float* x = P.in[0]; const float* meta = P.in[1]; bf16_t* HB = (bf16_t*)(P.ws + WS_HB); unsigned* ctl = (unsigned*)(P.ws + WS_CTL);
        for (int r = gw; r < MP; r += NGW) {
            const float* src = r < NMETA ? meta + (size_t)r * DM : (r < LTOK ? x + (size_t)(r - NMETA) * DM : nullptr);
#pragma unroll
            for (int j = 0; j < 8; ++j) { const int c = (lane + 64 * j) * 4; f32x4 v = {0.f, 0.f, 0.f, 0.f}; if (src) v = *(const f32x4*)(src + c);
                u32x2 w; w.x = cvt_pk_bf16(v[0], v[1]); w.y = cvt_pk_bf16(v[2], v[3]); *(u32x2*)(HB + (size_t)r * DM + c) = w; }
        }
        convert_weights(P, 0, 1, lds, gw, NGW, wid, lane);
        zero_pad_rows(P);
        if (blockIdx.x == 0 && tid < 64) ctl[tid] = 0u;
    } } }
    PH_SYNC(0);
    run_layer<0>(P0, lds);
    run_layer<1>(P0, lds);
}

extern "C" void kernel_launch(void* const* d_in, const int* in_sizes, int n_in, void* d_out, int out_size, void* d_ws, size_t ws_size, hipStream_t stream) {
    static int grid = 0;
    if (grid == 0) {
        if (n_in != 17 || in_sizes[0] != SEQ * DM || out_size != SEQ * DM || ws_size < WS_END) { fprintf(stderr, "kernel_launch: unexpected shapes (n_in %d, in0 %d, out %d, ws %zu)\n", n_in, n_in > 0 ? in_sizes[0] : -1, out_size, ws_size); grid = -1; return; }
        int dev = 0, cus = 0, per_cu = 0;
        (void)hipGetDevice(&dev); (void)hipDeviceGetAttribute(&cus, hipDeviceAttributeMultiprocessorCount, dev);
        if (hipFuncSetAttribute((const void*)hymba_fwd, hipFuncAttributeMaxDynamicSharedMemorySize, LDS_BYTES) != hipSuccess) { fprintf(stderr, "kernel_launch: hipFuncSetAttribute failed\n"); grid = -1; return; }
        if (hipOccupancyMaxActiveBlocksPerMultiprocessor(&per_cu, (const void*)hymba_fwd, 512, LDS_BYTES) != hipSuccess || per_cu < 1) { fprintf(stderr, "kernel_launch: occupancy query says %d\n", per_cu); per_cu = 1; }
        (void)hipGetLastError();
        grid = cus > 0 ? cus : 256;
    }
    if (grid < 0) return;
    if (hipMemsetAsync((char*)d_ws + WS_CTL, 0, 32768, stream) != hipSuccess) { fprintf(stderr, "kernel_launch: memset failed\n"); return; }
    Params p{};
    for (int i = 0; i < 17; ++i) p.in[i] = (const float*)d_in[i];
    p.out = (float*)d_out; p.ws = (unsigned char*)d_ws;
#if MK_SINGLE
    p.ph_lo = 0; p.ph_hi = NPHASE;
    void* args[] = {&p};
    hipError_t e = hipLaunchCooperativeKernel((const void*)hymba_fwd, dim3(grid), dim3(512), args, LDS_BYTES, stream);
    if (e != hipSuccess) fprintf(stderr, "cooperative launch failed: %s (grid %d)\n", hipGetErrorString(e), grid);
#else
    for (int ph = 0; ph < NPHASE; ++ph) { p.ph_lo = ph; p.ph_hi = ph + 1; hipLaunchKernelGGL(hymba_fwd, dim3(grid), dim3(512), LDS_BYTES, stream, p); }
#endif
}
```
